# Optimizing an MI355X kernel written in HIP

```python
import math
import jax, jax.numpy as jnp
from jax import lax
import numpy as np

D_MODEL = 2048
BATCH = 8
SEQ = 2048
DEPTH = 1

EPS = 1e-6
D_ATTN = D_MODEL // 2
ATTN_HEAD_DIM = 64
N_ATTN_HEADS = D_ATTN // ATTN_HEAD_DIM
DILATED_CONFIGS = ((128, 1), (512, 4), (2048, 16))
N_BUCKETS = 32
MAX_EXACT = N_BUCKETS // 2
MAX_DISTANCE = 2048
N_GLA_HEADS = 4
D_GLA_V = D_MODEL // 2
D_GLA_K = D_GLA_V // 2
GLA_DK = D_GLA_K // N_GLA_HEADS
GLA_DV = D_GLA_V // N_GLA_HEADS
GLA_GATE_RANK = 16
GLA_GATE_TEMP = 16.0
GLA_CHUNK = 64
D_MIX = D_ATTN + D_GLA_V
IN_SPLITS = (D_ATTN, D_ATTN, D_ATTN, D_GLA_K, D_GLA_K, D_GLA_V, GLA_GATE_RANK, D_GLA_V)
D_IN = D_ATTN * 3 + D_GLA_K * 2 + D_GLA_V * 2 + GLA_GATE_RANK
PEER_HEADS = 8
PEER_N_KEYS = 128
PEER_N_EXPERTS = PEER_N_KEYS * PEER_N_KEYS
PEER_TOPK = 16
PEER_QUERY_DIM = 256
PEER_TOKEN_BLOCK = 128

kernel_name = "hybrid_dilated_gla_peer_block"


def rms_norm(x, g):
    xf = x.astype(jnp.float32)
    y = xf * lax.rsqrt(jnp.mean(xf * xf, axis=-1, keepdims=True) + EPS)
    return (y * g.astype(jnp.float32)).astype(x.dtype)


def t5_bucket(dist):
    nf = jnp.maximum(dist, 1).astype(jnp.float32)
    large = MAX_EXACT + (jnp.log(nf / MAX_EXACT) / math.log(MAX_DISTANCE / MAX_EXACT)
                         * (N_BUCKETS - MAX_EXACT)).astype(jnp.int32)
    large = jnp.minimum(large, N_BUCKETS - 1)
    return jnp.where(dist < MAX_EXACT, dist, large)


def dilated_branch(q, k, v, rel_bias, window, dilation):
    B, H, S, hd = q.shape
    d = dilation
    W = window // dilation
    L = S // d
    nb = -(-L // W)
    Lp = nb * W

    def to_blocks(t):
        t = t.reshape(B, H, L, d, hd).transpose(0, 1, 3, 2, 4)
        t = jnp.pad(t, ((0, 0), (0, 0), (0, 0), (0, Lp - L), (0, 0)))
        return t.reshape(B, H, d, nb, W, hd)

    qb, kb, vb = to_blocks(q), to_blocks(k), to_blocks(v)

    def with_prev(t):
        prev = jnp.pad(t[:, :, :, :-1], ((0, 0), (0, 0), (0, 0), (1, 0), (0, 0), (0, 0)))
        return jnp.concatenate([prev, t], axis=-2)

    kk, vv = with_prev(kb), with_prev(vb)
    a = jnp.arange(W)[:, None]
    c = jnp.arange(2 * W)[None, :]
    delta = W + a - c
    blk = jnp.arange(nb)[:, None, None]
    valid = (delta >= 0) & (delta <= W) & (blk * W + c - W >= 0)
    bucket = t5_bucket(jnp.maximum(delta, 0) * d)
    bias = rel_bias[bucket].transpose(2, 0, 1).astype(jnp.float32)

    s = jnp.einsum('bhrnqe,bhrnke->bhrnqk', qb, kk).astype(jnp.float32) * (hd ** -0.5)
    s = s + bias[None, :, None, None]
    s = jnp.where(valid[None, None, None], s, -jnp.inf)
    m = jnp.max(s, axis=-1, keepdims=True)
    p = jnp.exp(s - m)
    den = jnp.sum(p, axis=-1, keepdims=True)
    o = jnp.einsum('bhrnqk,bhrnke->bhrnqe', p, vv.astype(jnp.float32)) / den
    lse = m + jnp.log(den)

    def from_blocks(t):
        e = t.shape[-1]
        t = t.reshape(B, H, d, Lp, e)[:, :, :, :L]
        return t.transpose(0, 1, 3, 2, 4).reshape(B, H, S, e)

    return from_blocks(o), from_blocks(lse)[..., 0]


def dilated_attention(q, k, v, rel_bias):
    outs, lses = [], []
    for window, dilation in DILATED_CONFIGS:
        o, l = dilated_branch(q, k, v, rel_bias, window, dilation)
        outs.append(o)
        lses.append(l)
    wts = jax.nn.softmax(jnp.stack(lses, 0), axis=0)
    return jnp.einsum('gbhs,gbhse->bhse', wts, jnp.stack(outs, 0))


def gla_chunked(q, k, v, log_a):
    B, H, S, dk = q.shape
    dv = v.shape[-1]
    C = GLA_CHUNK
    N = S // C
    q = q.reshape(B, H, N, C, dk)
    k = k.reshape(B, H, N, C, dk)
    v = v.reshape(B, H, N, C, dv)
    b = jnp.cumsum(log_a.reshape(B, H, N, C, dk), axis=-2)
    b_last = b[..., C - 1:, :]
    b_ref = b[..., C // 2 - 1:C // 2, :]
    attn = jnp.einsum('bhnik,bhnjk->bhnij', q * jnp.exp(b - b_ref), k * jnp.exp(b_ref - b))
    causal = jnp.tril(jnp.ones((C, C), dtype=bool))
    attn = jnp.where(causal, attn, 0.0)
    o_intra = jnp.einsum('bhnij,bhnjv->bhniv', attn, v)
    kv = jnp.einsum('bhnck,bhncv->bhnkv', k * jnp.exp(b_last - b), v)
    decay = jnp.exp(b_last[..., 0, :])

    def step(state, inp):
        kv_n, dec_n = inp
        return dec_n[..., None] * state + kv_n, state

    _, states = lax.scan(step, jnp.zeros((B, H, dk, dv), jnp.float32),
                         (jnp.moveaxis(kv, 2, 0), jnp.moveaxis(decay, 2, 0)))
    states = jnp.moveaxis(states, 0, 2)
    o_inter = jnp.einsum('bhnck,bhnkv->bhncv', q * jnp.exp(b), states)
    return (o_intra + o_inter).reshape(B, H, S, dv)


def peer_ffn(xn, w_query, keys1, keys2, u, v):
    B, S, D = xn.shape
    T = B * S
    xt = xn.reshape(T, D)
    q = (xt @ w_query).reshape(T, PEER_HEADS, 2, PEER_QUERY_DIM // 2)
    s1 = jnp.einsum('thc,kc->thk', q[:, :, 0], keys1).astype(jnp.float32)
    s2 = jnp.einsum('thc,kc->thk', q[:, :, 1], keys2).astype(jnp.float32)
    v1, i1 = lax.top_k(s1, PEER_TOPK)
    v2, i2 = lax.top_k(s2, PEER_TOPK)
    cand = (v1[..., :, None] + v2[..., None, :]).reshape(T, PEER_HEADS, PEER_TOPK * PEER_TOPK)
    cand_idx = (i1[..., :, None] * PEER_N_KEYS + i2[..., None, :]).reshape(T, PEER_HEADS, PEER_TOPK * PEER_TOPK)
    top_s, pos = lax.top_k(cand, PEER_TOPK)
    experts = jnp.take_along_axis(cand_idx, pos, axis=-1)
    gates = jax.nn.softmax(top_s, axis=-1).astype(xn.dtype)
    nblk = T // PEER_TOKEN_BLOCK

    def block(args):
        xb, eb, gb = args
        ue = u[eb]
        act = jax.nn.gelu(jnp.einsum('thkd,td->thk', ue, xb), approximate=False)
        return jnp.einsum('thk,thkd->td', gb * act, v[eb])

    out = lax.map(block, (xt.reshape(nblk, PEER_TOKEN_BLOCK, D),
                          experts.reshape(nblk, PEER_TOKEN_BLOCK, PEER_HEADS, PEER_TOPK),
                          gates.reshape(nblk, PEER_TOKEN_BLOCK, PEER_HEADS, PEER_TOPK)))
    return out.reshape(B, S, D)


def split_heads(t, n_heads):
    B, S, E = t.shape
    return t.reshape(B, S, n_heads, E // n_heads).transpose(0, 2, 1, 3)


def merge_heads(t):
    B, H, S, e = t.shape
    return t.transpose(0, 2, 1, 3).reshape(B, S, H * e)


def setup_inputs(seed: int = 0) -> dict:
    key = jax.random.key(seed)
    ks = jax.random.split(key, 16)
    f32 = jnp.float32
    nrm = lambda k, shape, scale: jax.random.normal(k, shape, f32) * scale
    return {
        "x": nrm(ks[0], (BATCH, SEQ, D_MODEL), 1.0),
        "ln1_g": 1.0 + nrm(ks[1], (DEPTH, D_MODEL), 0.02),
        "w_in": nrm(ks[2], (DEPTH, D_MODEL, D_IN), D_MODEL ** -0.5),
        "rel_bias": nrm(ks[3], (N_BUCKETS, N_ATTN_HEADS), 0.1),
        "gla_w_gate2": nrm(ks[4], (DEPTH, GLA_GATE_RANK, D_GLA_K), GLA_GATE_RANK ** -0.5),
        "gla_b_gate": nrm(ks[5], (DEPTH, D_GLA_K), 0.1),
        "gla_norm_g": 1.0 + nrm(ks[6], (DEPTH, N_GLA_HEADS, GLA_DV), 0.02),
        "w_out": nrm(ks[7], (DEPTH, D_MIX, D_MODEL), D_MIX ** -0.5),
        "ln2_g": 1.0 + nrm(ks[8], (DEPTH, D_MODEL), 0.02),
        "peer_w_query": nrm(ks[9], (DEPTH, D_MODEL, PEER_HEADS * PEER_QUERY_DIM), D_MODEL ** -0.5),
        "peer_keys1": nrm(ks[10], (DEPTH, PEER_N_KEYS, PEER_QUERY_DIM // 2), (PEER_QUERY_DIM // 2) ** -0.5),
        "peer_keys2": nrm(ks[11], (DEPTH, PEER_N_KEYS, PEER_QUERY_DIM // 2), (PEER_QUERY_DIM // 2) ** -0.5),
        "peer_u": nrm(ks[12], (DEPTH, PEER_N_EXPERTS, D_MODEL), D_MODEL ** -0.5),
        "peer_v": nrm(ks[13], (DEPTH, PEER_N_EXPERTS, D_MODEL), PEER_HEADS ** -0.5),
        "ln_f_g": 1.0 + nrm(ks[14], (D_MODEL,), 0.02),
    }


def reference(x, ln1_g, w_in, rel_bias, gla_w_gate2, gla_b_gate, gla_norm_g, w_out,
              ln2_g, peer_w_query, peer_keys1, peer_keys2, peer_u, peer_v, ln_f_g):
    h = x
    for l in range(DEPTH):
        xn = rms_norm(h, ln1_g[l])
        proj = xn @ w_in[l]
        bounds = []
        acc = 0
        for w in IN_SPLITS[:-1]:
            acc += w
            bounds.append(acc)
        aq, ak, av, gq, gk, gv, ga, gr = jnp.split(proj, bounds, axis=-1)
        attn_o = dilated_attention(split_heads(aq, N_ATTN_HEADS), split_heads(ak, N_ATTN_HEADS),
                                   split_heads(av, N_ATTN_HEADS), rel_bias)
        attn_o = merge_heads(attn_o).astype(h.dtype)
        gate_logit = (ga @ gla_w_gate2[l] + gla_b_gate[l]).astype(jnp.float32)
        log_a = jax.nn.log_sigmoid(gate_logit) / GLA_GATE_TEMP
        gla_o = gla_chunked(split_heads(gq, N_GLA_HEADS).astype(jnp.float32) * (GLA_DK ** -0.5),
                            split_heads(gk, N_GLA_HEADS).astype(jnp.float32),
                            split_heads(gv, N_GLA_HEADS).astype(jnp.float32),
                            split_heads(log_a, N_GLA_HEADS))
        gla_o = rms_norm(gla_o, gla_norm_g[l][:, None, :])
        gla_o = (merge_heads(gla_o) * jax.nn.silu(gr.astype(jnp.float32))).astype(h.dtype)
        mix = jnp.concatenate([attn_o, gla_o], axis=-1) @ w_out[l]
        h = h + mix
        hn = rms_norm(h, ln2_g[l])
        h = h + peer_ffn(hn, peer_w_query[l], peer_keys1[l], peer_keys2[l], peer_u[l], peer_v[l])
    return rms_norm(h, ln_f_g)
```

```cpp
#include <hip/hip_runtime.h>
#include <cstdio>
#include <cstdint>
#include <cmath>
namespace pg8 {
#define PG8_LAS __attribute__((address_space(3)))
typedef unsigned short bf16_t;
typedef short bf16x8 __attribute__((ext_vector_type(8)));
typedef float f32x4 __attribute__((ext_vector_type(4)));
typedef unsigned u32x4 __attribute__((ext_vector_type(4)));
constexpr int BM = 256, BK = 64, HALF = 128, HTB = HALF * BK * 2  , STAGE_BYTES = 8 * HTB, NXCD = 8, WGM = 8;

__host__ __device__ __forceinline__ int lds_byte(int r, int c) { const int st = (r >> 4) * 2 + (c >> 5), rr = r & 15, cc = c & 31, ob = rr * 64 + cc * 2; return st * 1024 + (ob ^ (((ob >> 9) & 1) << 5)); }
__host__ __device__ __forceinline__ void stage_rc(int b, int& R, int& C) { const int st = b / 1024, sb = b % 1024, swz = sb ^ (((sb >> 9) & 1) << 5); R = (st >> 1) * 16 + swz / 64; C = (st & 1) * 32 + (swz % 64) / 2; }
__host__ __device__ __forceinline__ int perm32(int rho) { const int n = rho >> 4, i = rho & 15; return 8 * (i >> 2) + 4 * n + (i & 3); }

struct Unit { int pm, pn; };
struct Gemm { const bf16_t* A; const bf16_t* Bt; int M, N, K; };

struct StaticOrder {
    int nM, nN, nwg, G, c;
    __host__ __device__ void init(int M, int N, int G_, int c_) { nM = M / BM; nN = N / BM; nwg = nM * nN; G = G_; c = c_; }
    __host__ __device__ bool next(int i, Unit& u) const {
        const long L = (long)i * G + c; if (L >= nwg) return false;
        int wgid = (int)L; { const int q = nwg / NXCD, r = nwg % NXCD, xcd = wgid % NXCD, off = wgid / NXCD; wgid = (xcd < r ? xcd * (q + 1) : r * (q + 1) + (xcd - r) * q) + off; }
        const int nig = WGM * nN, gid = wgid / nig, fm = gid * WGM, gsz = (nM - fm) < WGM ? (nM - fm) : WGM;
        u.pm = fm + ((wgid % nig) % gsz); u.pn = (wgid % nig) / gsz; return true;
    }
    __device__ __forceinline__ void a_ready(const Unit&) const {}
    __device__ __forceinline__ void done(const Unit&) const {}
};

__device__ __forceinline__ unsigned cvt_pk_bf16(float lo, float hi) { unsigned r; asm volatile("v_cvt_pk_bf16_f32 %0, %1, %2" : "=v"(r) : "v"(lo), "v"(hi)); return r; }
typedef float f32x2 __attribute__((ext_vector_type(2)));
__device__ __forceinline__ f32x2 gelu_pk(f32x2 v) {
    const f32x2 av = __builtin_elementwise_abs(v), d = av * 0.2316418882f + 1.0f;
    f32x2 t; t.x = __builtin_amdgcn_rcpf(d.x); t.y = __builtin_amdgcn_rcpf(d.y);
    f32x2 q = t * 0.5307027145f + (-0.7265760135f); q = q * t + 0.7107068705f; q = q * t + (-0.142248368f); q = q * t + 0.127414796f; q = q * t;
    const f32x2 s = (v * v) * (-0.72134752044f);
    f32x2 e; e.x = __builtin_amdgcn_exp2f(s.x); e.y = __builtin_amdgcn_exp2f(s.y);
    const f32x2 m = v * (q * e), r = v - m;
    f32x2 o; o.x = v.x < 0.f ? m.x : r.x; o.y = v.y < 0.f ? m.y : r.y; return o;
}

template <int ACT  > struct EpiBf16 {
    static constexpr bool PERM = true, AFTER_DRAIN = false; static_assert(ACT == 0 || ACT == 1, "EpiBf16: ACT is 0 (none) or 1 (gelu_pk)");
    bf16_t* O; int ldc; const float* bias; int split_cols; size_t split_stride; float scale0;
    __device__ __forceinline__ void operator()(const f32x4 (&acc)[2][2][4][2], const Unit& u, int wr, int wc, int fr, int fq) const {
        const int row0 = u.pm * BM + wr * 64 + fr; int colt = u.pn * BM; bf16_t* base = O;
        float sc = 1.f; if (split_cols) { const int t = colt / split_cols; base += (size_t)t * split_stride; colt -= t * split_cols; if (t == 0) sc = scale0; }
        const int col0 = colt + wc * 32 + 8 * fq, bcol0 = u.pn * BM + wc * 32 + 8 * fq;
        f32x4 bv[2][2];
#pragma unroll
        for (int bj = 0; bj < 2; ++bj)
#pragma unroll
            for (int n = 0; n < 2; ++n) bv[bj][n] = bias ? *(const f32x4*)(bias + bcol0 + bj * HALF + 4 * n) : (f32x4){0.f, 0.f, 0.f, 0.f};
#pragma unroll
        for (int ai = 0; ai < 2; ++ai)
#pragma unroll
            for (int m = 0; m < 4; ++m) { bf16_t* rowp = base + (size_t)(row0 + ai * HALF + m * 16) * ldc + col0;
#pragma unroll
                for (int bj = 0; bj < 2; ++bj) { f32x4 v0 = acc[ai][bj][m][0] + bv[bj][0], v1 = acc[ai][bj][m][1] + bv[bj][1];
                    if (ACT == 1) { f32x2 a = gelu_pk((f32x2){v0[0], v0[1]}), b = gelu_pk((f32x2){v0[2], v0[3]}), c = gelu_pk((f32x2){v1[0], v1[1]}), d = gelu_pk((f32x2){v1[2], v1[3]});
                        v0 = (f32x4){a.x, a.y, b.x, b.y}; v1 = (f32x4){c.x, c.y, d.x, d.y}; }
                    v0 = v0 * sc; v1 = v1 * sc; u32x4 w; w.x = cvt_pk_bf16(v0[0], v0[1]); w.y = cvt_pk_bf16(v0[2], v0[3]); w.z = cvt_pk_bf16(v1[0], v1[1]); w.w = cvt_pk_bf16(v1[2], v1[3]);
                    *(u32x4*)(rowp + bj * HALF) = w; } }
    }
};

template <class Epi, class Sched, bool ALIGN_EPI = false, bool SP2 = false, bool FP8 = false>
__device__ __forceinline__ void gemm_phase(PG8_LAS unsigned char* lds, const Gemm g, const Sched& S, const Epi& E) {
    const int tid = threadIdx.x, wid = __builtin_amdgcn_readfirstlane(tid >> 6), lane = tid & 63, wr = wid >> 2, wc = wid & 3, fr = lane & 15, fq = lane >> 4;
    const int K = g.K, nt = K / BK;
    unsigned voffA[2], voffB[2];
#pragma unroll
    for (int i = 0; i < 2; ++i) { int R, C; stage_rc(tid * 16 + i * 8192, R, C); const int Rb = Epi::PERM ? ((R & ~31) + perm32(R & 31)) : R;
        voffA[i] = (unsigned)(R * K + C) * 2u; voffB[i] = (unsigned)(Rb * K + C) * 2u; }
    const size_t kstep = (size_t)(BK * 2);
    const size_t hstep = (size_t)HALF * K * 2;
    const size_t tstep = 2 * hstep;
    const unsigned ldsw = (unsigned)wid * 1024u;
    const int aoff = lds_byte(wr * 64 + fr, fq * 8), boff = lds_byte(wc * 32 + fr, fq * 8);
#define PG8_SA(b, h) (((b) * 2 + (h)) * HTB)
#define PG8_SB(b, h) ((4 + (b) * 2 + (h)) * HTB)
#define PG8_STAGE(bufoff, gbase, voff) do { _Pragma("unroll") for (int _i = 0; _i < 2; ++_i) \
        __builtin_amdgcn_global_load_lds((const unsigned*)((const char*)(gbase) + (voff)[_i]), (PG8_LAS unsigned*)(lds + (bufoff) + ldsw + _i * 8192), 16, 0, 0); } while (0)
#define PG8_LDA(dst, b, h) do { if constexpr (FP8) { _Pragma("unroll") for (int m = 0; m < 4; ++m) { const pg8_v4i lo_ = *(const PG8_LAS pg8_v4i*)(lds + PG8_SA(b, h) + aoff + m * 2048), hi_ = *(const PG8_LAS pg8_v4i*)(lds + PG8_SA(b, h) + aoff + m * 2048 + 1024); \
            dst##8[m] = __builtin_shufflevector(lo_, hi_, 0, 1, 2, 3, 4, 5, 6, 7); } } \
        else { _Pragma("unroll") for (int m = 0; m < 4; ++m) _Pragma("unroll") for (int k = 0; k < 2; ++k) dst[m][k] = *(const PG8_LAS bf16x8*)(lds + PG8_SA(b, h) + aoff + m * 2048 + k * 1024); } } while (0)
#define PG8_LDB(dst, b, h) do { if constexpr (FP8) { _Pragma("unroll") for (int n = 0; n < 2; ++n) { const pg8_v4i lo_ = *(const PG8_LAS pg8_v4i*)(lds + PG8_SB(b, h) + boff + n * 2048), hi_ = *(const PG8_LAS pg8_v4i*)(lds + PG8_SB(b, h) + boff + n * 2048 + 1024); \
            dst##8[n] = __builtin_shufflevector(lo_, hi_, 0, 1, 2, 3, 4, 5, 6, 7); } } \
        else { _Pragma("unroll") for (int n = 0; n < 2; ++n) _Pragma("unroll") for (int k = 0; k < 2; ++k) dst[n][k] = *(const PG8_LAS bf16x8*)(lds + PG8_SB(b, h) + boff + n * 2048 + k * 1024); } } while (0)
#define PG8_MMA(ai, bj, At, Bt) do { __builtin_amdgcn_s_setprio(1); _Pragma("unroll") for (int m = 0; m < 4; ++m) _Pragma("unroll") for (int n = 0; n < 2; ++n) { \
        if constexpr (FP8) asm volatile("v_mfma_f32_16x16x128_f8f6f4 %0, %1, %2, %0" : "+v"(acc[ai][bj][m][n]) : "v"(Bt##8[n]), "v"(At##8[m]));     \
        else { _Pragma("unroll") for (int k = 0; k < 2; ++k) acc[ai][bj][m][n] = __builtin_amdgcn_mfma_f32_16x16x32_bf16(Bt[n][k], At[m][k], acc[ai][bj][m][n], 0, 0, 0); } } \
        __builtin_amdgcn_s_setprio(0); } while (0)
#define PG8_WAIT_V(n) asm volatile("s_waitcnt vmcnt(" #n ")" ::: "memory")
#define PG8_WAIT_L(n) asm volatile("s_waitcnt lgkmcnt(" #n ")" ::: "memory")
#define PG8_BAR __builtin_amdgcn_s_barrier()
#define PG8_SCHED __builtin_amdgcn_sched_barrier(0)
    Unit cur, nxt; int ui = 0;
    if (!S.next(0, cur)) return;
    f32x4 acc[2][2][4][2];
#pragma unroll
    for (int a = 0; a < 2; ++a)
#pragma unroll
        for (int b = 0; b < 2; ++b)
#pragma unroll
            for (int m = 0; m < 4; ++m)
#pragma unroll
                for (int n = 0; n < 2; ++n) acc[a][b][m][n] = (f32x4){0.f, 0.f, 0.f, 0.f};
    typedef int pg8_v4i __attribute__((ext_vector_type(4))); typedef int pg8_v8i __attribute__((ext_vector_type(8)));
    bf16x8 At[4][2], B0[2][2], B1[2][2]; pg8_v8i At8[4], B08[2], B18[2];
    const char* cA = (const char*)g.A + (size_t)cur.pm * tstep; const char* cB = (const char*)g.Bt + (size_t)cur.pn * tstep;
    S.a_ready(cur);
    if constexpr (SP2) {
        PG8_STAGE(PG8_SB(0, 0), cB, voffB); PG8_STAGE(PG8_SB(0, 1), cB + hstep, voffB); PG8_STAGE(PG8_SA(0, 0), cA, voffA); PG8_STAGE(PG8_SA(0, 1), cA + hstep, voffA);
        if (wr == 1) PG8_BAR;
        PG8_WAIT_V(2); PG8_BAR;
        PG8_STAGE(PG8_SB(1, 0), cB + kstep, voffB); PG8_STAGE(PG8_SA(1, 0), cA + kstep, voffA); PG8_STAGE(PG8_SB(1, 1), cB + hstep + kstep, voffB);
        PG8_WAIT_V(6); PG8_BAR;
    } else {
        PG8_STAGE(PG8_SB(0, 0), cB, voffB); PG8_STAGE(PG8_SA(0, 0), cA, voffA); PG8_STAGE(PG8_SB(0, 1), cB + hstep, voffB); PG8_STAGE(PG8_SA(0, 1), cA + hstep, voffA);
        if (wr == 1) PG8_BAR;
        PG8_WAIT_V(4); PG8_BAR;
        PG8_STAGE(PG8_SB(1, 0), cB + kstep, voffB); PG8_STAGE(PG8_SA(1, 0), cA + kstep, voffA); PG8_STAGE(PG8_SB(1, 1), cB + hstep + kstep, voffB);
        PG8_WAIT_V(6); PG8_BAR;
    }
    for (;;) {
        const bool has_next = S.next(ui + 1, nxt);
        const char* nA = has_next ? (const char*)g.A + (size_t)nxt.pm * tstep : cA; const char* nB = has_next ? (const char*)g.Bt + (size_t)nxt.pn * tstep : cB;
        for (int t = 0; t < nt; t += 2) {
            const bool last = (t == nt - 2);
            const char* a1 = cA + (size_t)(t + 1) * kstep;
            const char* a2 = last ? nA : cA + (size_t)(t + 2) * kstep; const char* b2 = last ? nB : cB + (size_t)(t + 2) * kstep;
            const char* a3 = a2 + kstep; const char* b3 = b2 + kstep;
            if (last && has_next) S.a_ready(nxt);
            if constexpr (SP2) {
            PG8_LDB(B0, 0, 0); PG8_LDB(B1, 0, 1); PG8_SCHED; PG8_LDA(At, 0, 0); PG8_STAGE(PG8_SA(1, 1), a1 + hstep, voffA);
            PG8_WAIT_V(8); PG8_WAIT_L(0); PG8_BAR; PG8_MMA(0, 0, At, B0); PG8_MMA(0, 1, At, B1); PG8_BAR; PG8_SCHED;
            PG8_LDA(At, 0, 1); PG8_STAGE(PG8_SB(0, 0), b2, voffB); PG8_STAGE(PG8_SB(0, 1), b2 + hstep, voffB); PG8_STAGE(PG8_SA(0, 0), a2, voffA);
            PG8_WAIT_V(8); PG8_WAIT_L(0); PG8_BAR; PG8_MMA(1, 0, At, B0); PG8_MMA(1, 1, At, B1); PG8_BAR; PG8_SCHED;
            PG8_LDB(B0, 1, 0); PG8_LDB(B1, 1, 1); PG8_SCHED; PG8_LDA(At, 1, 0); PG8_STAGE(PG8_SA(0, 1), a2 + hstep, voffA);
            PG8_WAIT_V(8); PG8_WAIT_L(0); PG8_BAR; PG8_MMA(0, 0, At, B0); PG8_MMA(0, 1, At, B1); PG8_BAR; PG8_SCHED;
            PG8_LDA(At, 1, 1); PG8_STAGE(PG8_SB(1, 0), b3, voffB); PG8_STAGE(PG8_SB(1, 1), b3 + hstep, voffB); PG8_STAGE(PG8_SA(1, 0), a3, voffA);
            PG8_WAIT_V(8); PG8_WAIT_L(0); PG8_BAR; PG8_MMA(1, 0, At, B0); PG8_MMA(1, 1, At, B1); PG8_BAR; PG8_SCHED;
            } else {
            PG8_LDB(B0, 0, 0); PG8_SCHED; PG8_LDA(At, 0, 0); PG8_STAGE(PG8_SA(1, 1), a1 + hstep, voffA);
            PG8_WAIT_L(8); PG8_BAR; PG8_WAIT_L(0); PG8_MMA(0, 0, At, B0); PG8_BAR; PG8_SCHED;
            PG8_LDB(B1, 0, 1); PG8_STAGE(PG8_SB(0, 0), b2, voffB);
            PG8_BAR; PG8_WAIT_L(0); PG8_MMA(0, 1, At, B1); PG8_BAR;
            PG8_LDA(At, 0, 1); PG8_STAGE(PG8_SA(0, 0), a2, voffA);
            PG8_BAR; PG8_WAIT_L(0); PG8_MMA(1, 0, At, B0); PG8_BAR; PG8_SCHED;
            PG8_STAGE(PG8_SB(0, 1), b2 + hstep, voffB);
            PG8_WAIT_V(6); PG8_BAR; PG8_MMA(1, 1, At, B1); PG8_BAR;
            PG8_LDB(B0, 1, 0); PG8_SCHED; PG8_LDA(At, 1, 0); PG8_STAGE(PG8_SA(0, 1), a2 + hstep, voffA);
            PG8_WAIT_L(8); PG8_BAR; PG8_WAIT_L(0); PG8_MMA(0, 0, At, B0); PG8_BAR; PG8_SCHED;
            PG8_LDB(B1, 1, 1); PG8_STAGE(PG8_SB(1, 0), b3, voffB);
            PG8_BAR; PG8_WAIT_L(0); PG8_MMA(0, 1, At, B1); PG8_BAR;
            PG8_LDA(At, 1, 1); PG8_STAGE(PG8_SA(1, 0), a3, voffA);
            PG8_BAR; PG8_WAIT_L(0); PG8_MMA(1, 0, At, B0); PG8_BAR; PG8_SCHED;
            PG8_STAGE(PG8_SB(1, 1), b3 + hstep, voffB);
            PG8_WAIT_V(6); PG8_BAR; PG8_MMA(1, 1, At, B1); PG8_BAR;
            }
        }
        if constexpr (ALIGN_EPI) { if (wr == 0) PG8_BAR; }
        if constexpr (FP8) asm volatile("s_nop 15\n\ts_nop 15\n\ts_nop 15" ::: "memory");
        if constexpr (!Epi::AFTER_DRAIN) {
            if constexpr (FP8) { const int l2_ = (int)__builtin_amdgcn_mbcnt_hi(~0u, __builtin_amdgcn_mbcnt_lo(~0u, 0u));
                E(acc, cur, wr, wc, l2_ & 15, l2_ >> 4); }
            else E(acc, cur, wr, wc, fr, fq);
            S.done(cur); }
        if (!has_next) break;
#pragma unroll
        for (int a = 0; a < 2; ++a)
#pragma unroll
            for (int b = 0; b < 2; ++b)
#pragma unroll
                for (int m = 0; m < 4; ++m)
#pragma unroll
                    for (int n = 0; n < 2; ++n) acc[a][b][m][n] = (f32x4){0.f, 0.f, 0.f, 0.f};
        cur = nxt; cA = nA; cB = nB; ++ui;
        if constexpr (ALIGN_EPI) { if (wr == 1) PG8_BAR; }
    }
    PG8_WAIT_V(0);
    if constexpr (!ALIGN_EPI) { if (wr == 0) PG8_BAR; }
    PG8_BAR;
    if constexpr (Epi::AFTER_DRAIN) { E.fused(acc, cur, wr, wc, fr, fq, lds, wid, lane); S.done(cur); }
#undef PG8_SA
#undef PG8_SB
#undef PG8_STAGE
#undef PG8_LDA
#undef PG8_LDB
#undef PG8_MMA
#undef PG8_WAIT_V
#undef PG8_WAIT_L
#undef PG8_BAR
#undef PG8_SCHED
}
}

constexpr int NWAVES = 8;
#ifndef MK_N_LAUNCHES
#define MK_N_LAUNCHES 1
#endif
constexpr int N_LAUNCHES = MK_N_LAUNCHES;
constexpr int PER_PHASE = 8;

constexpr int BATCH = 8, SEQ = 2048, DM = 2048, T = BATCH * SEQ;
constexpr int NH = 16, HD = 64;
constexpr int NGH = 4, GDK = 128, GDV = 256, GRANK = 16;
constexpr int DIN = 6160, NPROJ = 6144;
constexpr int C_AQ = 0, C_AK = 1024, C_AV = 2048, C_GQ = 3072, C_GK = 3584, C_GV = 4096, C_GR = 5120;
constexpr int PEH = 8, PEK = 128, PETOP = 16, NEXP = 16384;
constexpr float EPS = 1e-6f;
constexpr float LOG2E = 1.4426950408889634f;
constexpr float QSCALE = 0.125f * LOG2E;
constexpr float GQSCALE = 0.08838834764831845f;

constexpr size_t MiB = 1u << 20;
constexpr size_t WS_CTL = 0, CTL_ZERO_BYTES = 32 * 1024;
constexpr size_t WS_WIN = 1 * MiB;
constexpr size_t WS_WOUT = 26 * MiB;
constexpr size_t WS_WQ = 34 * MiB;
constexpr size_t WS_XN = 42 * MiB;
constexpr size_t WS_PROJ = 106 * MiB;
constexpr size_t WS_U = 298 * MiB;
constexpr size_t WS_V = 330 * MiB;
constexpr size_t WS_SC = 362 * MiB;
constexpr size_t WS_MIX = 363 * MiB;
constexpr size_t WS_GA = 427 * MiB;
constexpr size_t WS_IDX = 428 * MiB;
constexpr size_t WS_GATE = 436 * MiB;
constexpr size_t WS_LB = 444 * MiB;
constexpr size_t WS_HN = 445 * MiB;
constexpr size_t WS_SSQ = 509 * MiB;
constexpr size_t WS_RSTD = 362 * MiB + 512 * 1024;
constexpr size_t WS_XQ8 = WS_PROJ + 64 * MiB;
constexpr size_t WS_XN8 = WS_HN;
constexpr size_t WS_WIN8 = WS_HN + 32 * MiB;
constexpr float WIN8_SCALE = 128.f;
constexpr int F8_A0 = 0, F8_A1 = 3072, F8_B0 = 4096, F8_B1 = 6144;
__host__ __device__ constexpr bool is_f8_col(int n) { return (n >= F8_A0 && n < F8_A1) || (n >= F8_B0 && n < F8_B1); }
constexpr size_t WS_RMS1 = 362 * MiB + 640 * 1024;
constexpr size_t WS_END = 511 * MiB;
constexpr int CW_TMO = 0, CW_CODE = 1, CW_ATTQ = 64, CW_BAR = 4096;

constexpr int RING_OFF = 0, RING_BYTES = 131072;
constexpr int LDS_BYTES = 147456;
constexpr int LDSCTL_OFF = LDS_BYTES - 512, MISC_OFF = LDSCTL_OFF + 320;

#define GAS __attribute__((address_space(1)))
#define LAS __attribute__((address_space(3)))
typedef unsigned short bf16;
typedef unsigned v4u __attribute__((ext_vector_type(4)));
typedef unsigned v2u __attribute__((ext_vector_type(2)));
typedef float f32x4 __attribute__((ext_vector_type(4)));
typedef short bf16x8 __attribute__((ext_vector_type(8)));
typedef GAS unsigned gu32;
#define RLX_AGENT __ATOMIC_RELAXED, __HIP_MEMORY_SCOPE_AGENT
#define LDS_WAIT() asm volatile("s_waitcnt lgkmcnt(0)" ::: "memory")
#define VM_WAIT() asm volatile("s_waitcnt vmcnt(0)" ::: "memory")
__device__ __forceinline__ unsigned f2bf(float f) { unsigned u = __builtin_bit_cast(unsigned, f); return (u + 0x7fffu + ((u >> 16) & 1u)) >> 16; }
__device__ __forceinline__ unsigned pk2(float lo, float hi) { return f2bf(lo) | (f2bf(hi) << 16); }
__device__ __forceinline__ float bf2f(unsigned short b) { return __builtin_bit_cast(float, (unsigned)b << 16); }
__device__ __forceinline__ float bflo(unsigned w) { return __builtin_bit_cast(float, w << 16); }
__device__ __forceinline__ float bfhi(unsigned w) { return __builtin_bit_cast(float, w & 0xffff0000u); }

#define XB_TMO      128
#define XB_XCNT(j)  (256  + 64 * (j))
#define XB_XSUB(j)  (1280 + 64 * (j))
#define XB_XGEN(j)  (2304 + 64 * (j))
#define XB_TOP      3328
#define XB_TOPGEN   3392
#define XCD_BAR_WORDS 3456
#define XB_SPIN_CAP (1u << 22)

__device__ __forceinline__ unsigned xb_ld(unsigned* p)              { return __hip_atomic_load(p, __ATOMIC_RELAXED, __HIP_MEMORY_SCOPE_AGENT); }
__device__ __forceinline__ unsigned xb_add(unsigned* p, unsigned v) { return __hip_atomic_fetch_add(p, v, __ATOMIC_RELAXED, __HIP_MEMORY_SCOPE_AGENT); }
__device__ __forceinline__ unsigned xb_xcc_id() { return (unsigned)__builtin_amdgcn_s_getreg((3 << 11) | 20) & 0xFu; }
#define XB_SPIN(cond, bar) do { unsigned _sp = 0; while (cond) { __builtin_amdgcn_s_sleep(1); \
    if ((++_sp & 255u) == 0u) { if (xb_ld(&(bar)[XB_TMO])) break; if (_sp > XB_SPIN_CAP) { atomicAdd(&(bar)[XB_TMO], 1u); break; } } } } while (0)

struct XcdBarrier { unsigned* bar; unsigned x; volatile LAS unsigned* st; };

__device__ __forceinline__ XcdBarrier xcd_barrier_post(unsigned* bar, volatile LAS unsigned* st) {
    XcdBarrier b; b.bar = bar; b.x = xb_xcc_id(); b.st = st;
    if (threadIdx.x == 0) (void)xb_add(&bar[XB_XCNT(b.x)], 1u);
    return b;
}
__device__ __forceinline__ void xcd_barrier_complete(unsigned* bar, unsigned x, unsigned& nloc, unsigned& nx) {
    const unsigned G = gridDim.x * gridDim.y * gridDim.z;
    unsigned sum, cnt, mine, sp = 0u;
    for (;;) {
        sum = 0u; cnt = 0u; mine = 0u;
#pragma unroll
        for (unsigned j = 0; j < 16; ++j) { const unsigned c = xb_ld(&bar[XB_XCNT(j)]); sum += c; cnt += (c > 0u) ? 1u : 0u; mine = (j == x) ? c : mine; }
        if (sum == G) break;
        __builtin_amdgcn_s_sleep(1);
        if ((++sp & 255u) == 0u) { if (xb_ld(&bar[XB_TMO])) break; if (sp > XB_SPIN_CAP) { atomicAdd(&bar[XB_TMO], 1u); break; } }
    }
    nloc = mine > 0u ? mine : 1u; nx = cnt > 0u ? cnt : 1u;
}
__device__ __forceinline__ void xcd_barrier(const XcdBarrier& b) {
    asm volatile("s_waitcnt vmcnt(0)" ::: "memory");
    __syncthreads();
    if (threadIdx.x == 0) {
        unsigned* bar = b.bar;
        __builtin_amdgcn_s_waitcnt(0);
        unsigned nloc = b.st[0], nx = b.st[1];
        if (nloc == 0u) { xcd_barrier_complete(bar, b.x, nloc, nx); b.st[0] = nloc; b.st[1] = nx; }
        const unsigned old = xb_add(&bar[XB_XSUB(b.x)], 1u);
        const unsigned gen = old / nloc;
        if (old + 1u == (gen + 1u) * nloc) {
            __builtin_amdgcn_fence(__ATOMIC_RELEASE, "agent");
            asm volatile("s_waitcnt vmcnt(0)" ::: "memory");
            const unsigned og = xb_add(&bar[XB_TOP], 1u);
            const unsigned tg = og / nx;
            if (og + 1u == (tg + 1u) * nx) xb_add(&bar[XB_TOPGEN], 1u);
            else XB_SPIN(xb_ld(&bar[XB_TOPGEN]) == tg, bar);
            __builtin_amdgcn_fence(__ATOMIC_ACQUIRE, "agent"); asm volatile("buffer_inv sc0 sc1" ::: "memory");
            xb_add(&bar[XB_XGEN(b.x)], 1u);
            asm volatile("s_waitcnt vmcnt(0)" ::: "memory");
        } else {
            XB_SPIN(xb_ld(&bar[XB_XGEN(b.x)]) == gen, bar);
            __builtin_amdgcn_fence(__ATOMIC_ACQUIRE, "agent"); asm volatile("buffer_inv sc0 sc1" ::: "memory");
            asm volatile("s_waitcnt vmcnt(0)" ::: "memory");
        }
    }
    __syncthreads();
}

namespace pg8 {
struct EpiProj {
    static constexpr bool PERM = true, AFTER_DRAIN = false;
    bf16_t* O; int ldc; float osc; int pn0;
    __device__ __forceinline__ void operator()(const f32x4 (&acc)[2][2][4][2], const Unit& u, int wr, int wc, int fr, int fq) const {
        const int row0 = u.pm * BM + wr * 64 + fr; const int col0 = (u.pn + pn0) * BM + wc * 32 + 8 * fq;
        const float sc = ((u.pn + pn0 < 4) ? QSCALE : 1.f) * osc;
#pragma unroll
        for (int ai = 0; ai < 2; ++ai)
#pragma unroll
            for (int m = 0; m < 4; ++m) { bf16_t* rowp = O + (size_t)(row0 + ai * HALF + m * 16) * ldc + col0;
#pragma unroll
                for (int bj = 0; bj < 2; ++bj) { f32x4 v0 = acc[ai][bj][m][0] * sc, v1 = acc[ai][bj][m][1] * sc;
                    u32x4 w; w.x = cvt_pk_bf16(v0[0], v0[1]); w.y = cvt_pk_bf16(v0[2], v0[3]); w.z = cvt_pk_bf16(v1[0], v1[1]); w.w = cvt_pk_bf16(v1[2], v1[3]);
                    *(u32x4*)(rowp + bj * HALF) = w; } }
    }
};
struct EpiRes {
    static constexpr bool PERM = false, AFTER_DRAIN = false;
    const float* base; float* C; int ldc;
    __device__ __forceinline__ void operator()(const f32x4 (&acc)[2][2][4][2], const Unit& u, int wr, int wc, int fr, int fq) const {
        const int row0 = u.pm * BM + wr * 64 + fr, col0 = u.pn * BM + wc * 32 + 4 * fq;
#pragma unroll
        for (int ai = 0; ai < 2; ++ai)
#pragma unroll
            for (int m = 0; m < 4; ++m) { const size_t off = (size_t)(row0 + ai * HALF + m * 16) * ldc + col0;
#pragma unroll
                for (int bj = 0; bj < 2; ++bj)
#pragma unroll
                    for (int n = 0; n < 2; ++n) *(f32x4*)(C + off + bj * HALF + n * 16) = acc[ai][bj][m][n] + *(const f32x4*)(base + off + bj * HALF + n * 16); }
    }
};
struct EpiRes2 {
    static constexpr bool PERM = true, AFTER_DRAIN = false;
    const bf16_t* XNb; const float* RMS1; const float* G1; bf16_t* CB; float* SSQ; int ldc; int M;
    __device__ __forceinline__ void operator()(const f32x4 (&acc)[2][2][4][2], const Unit& u, int wr, int wc, int fr, int fq) const {
        const int row0 = u.pm * BM + wr * 64 + fr, col0 = u.pn * BM + wc * 32 + 8 * fq;
        float* sq = SSQ + (size_t)(u.pn * 4 + wc) * M;
        f32x4 ig[2][2];
#pragma unroll
        for (int bj = 0; bj < 2; ++bj)
#pragma unroll
            for (int n = 0; n < 2; ++n) { const f32x4 g = *(const f32x4*)(G1 + col0 + bj * HALF + 4 * n); ig[bj][n] = (f32x4){1.f / g[0], 1.f / g[1], 1.f / g[2], 1.f / g[3]}; }
#pragma unroll
        for (int ai = 0; ai < 2; ++ai) {
            u32x4 xb[4][2]; float rm[4];
#pragma unroll
            for (int m = 0; m < 4; ++m)
#pragma unroll
                for (int bj = 0; bj < 2; ++bj) xb[m][bj] = *(const u32x4*)(XNb + (size_t)(row0 + ai * HALF + m * 16) * ldc + col0 + bj * HALF);
#pragma unroll
            for (int m = 0; m < 4; ++m) rm[m] = RMS1[row0 + ai * HALF + m * 16];
#pragma unroll
            for (int m = 0; m < 4; ++m) { const int row = row0 + ai * HALF + m * 16; const size_t off = (size_t)row * ldc + col0; float ss = 0.f;
#pragma unroll
                for (int bj = 0; bj < 2; ++bj) { const u32x4 xw = xb[m][bj];
                    const f32x4 x0 = (f32x4){bflo(xw.x), bfhi(xw.x), bflo(xw.y), bfhi(xw.y)} * rm[m] * ig[bj][0], x1 = (f32x4){bflo(xw.z), bfhi(xw.z), bflo(xw.w), bfhi(xw.w)} * rm[m] * ig[bj][1];
                    const f32x4 v0 = acc[ai][bj][m][0] + x0, v1 = acc[ai][bj][m][1] + x1;
                    u32x4 w; w.x = cvt_pk_bf16(v0[0], v0[1]); w.y = cvt_pk_bf16(v0[2], v0[3]); w.z = cvt_pk_bf16(v1[0], v1[1]); w.w = cvt_pk_bf16(v1[2], v1[3]);
                    *(u32x4*)(CB + off + bj * HALF) = w;
                    ss += (v0[0] * v0[0] + v0[1] * v0[1]) + (v0[2] * v0[2] + v0[3] * v0[3]) + (v1[0] * v1[0] + v1[1] * v1[1]) + (v1[2] * v1[2] + v1[3] * v1[3]); }
                ss += __shfl_xor(ss, 16); ss += __shfl_xor(ss, 32);
                if (fq == 0) sq[row] = ss; }
        }
    }
};
}

struct Frame {
    LAS unsigned char* lds;
    volatile LAS unsigned* MISC;
    gu32* ctl;
    int tid, lane, wave;
    int vcu, G;
    const float *x, *ln1g, *w_in, *rel_bias, *wg2, *bgate, *gng, *w_out, *ln2g, *w_q, *keys1, *keys2, *pu, *pv, *lnfg;
    float* out;
    bf16 *WinT, *WoutT, *WqT, *XN, *MIX, *HN, *PROJ, *PQ; unsigned char *U8, *V8;
    float *GA, *GATE, *LB, *SC, *SSQ, *RSTD, *RMS1; unsigned char *XQ8, *XN8, *WIN8; int* IDX;
};

__device__ __forceinline__ float wave_sum(float v) {
#pragma unroll
    for (int o = 1; o < 64; o <<= 1) v += __shfl_xor(v, o);
    return v;
}
__device__ __forceinline__ float wave_max(float v) {
#pragma unroll
    for (int o = 1; o < 64; o <<= 1) v = fmaxf(v, __shfl_xor(v, o));
    return v;
}

__device__ __forceinline__ unsigned q8pack(float a, float b_, float c, float d) {
    const int qa = (int)__builtin_rintf(a), qb = (int)__builtin_rintf(b_), qc = (int)__builtin_rintf(c), qd = (int)__builtin_rintf(d);
    return ((unsigned)qa & 255u) | (((unsigned)qb & 255u) << 8) | (((unsigned)qc & 255u) << 16) | ((unsigned)qd << 24);
}
__device__ __forceinline__ void transpose_item(const float* W, int K, int N, bf16* WT, int src_n0, int dst_n0, int ncols, int k0, LAS float* scr, int lane, const float* gk = nullptr, unsigned char* WT8 = nullptr) {
    const int ch = lane & 7, kr = lane >> 3; const bool ok = 4 * ch < ncols;
#pragma unroll
    for (int i = 0; i < 8; ++i) { const int kk = 8 * i + kr; f32x4 v = {0.f, 0.f, 0.f, 0.f};
        if (ok) v = *(const GAS f32x4*)(W + (size_t)(k0 + kk) * N + src_n0 + 4 * ch);
        LAS float* d = scr + kk * 33 + 4 * ch; d[0] = v.x; d[1] = v.y; d[2] = v.z; d[3] = v.w; }
    LDS_WAIT(); asm volatile("" ::: "memory");
    const int c = lane & 7;
    f32x4 g0 = {1.f, 1.f, 1.f, 1.f}, g1 = g0;
    if (gk) { g0 = *(const GAS f32x4*)(gk + k0 + 8 * c); g1 = *(const GAS f32x4*)(gk + k0 + 8 * c + 4); }
#pragma unroll
    for (int j = 0; j < 4; ++j) { const int n = (lane >> 3) + 8 * j; const LAS float* s = scr + (8 * c) * 33 + n;
        v4u o; o.x = pk2(s[0 * 33] * g0.x, s[1 * 33] * g0.y); o.y = pk2(s[2 * 33] * g0.z, s[3 * 33] * g0.w); o.z = pk2(s[4 * 33] * g1.x, s[5 * 33] * g1.y); o.w = pk2(s[6 * 33] * g1.z, s[7 * 33] * g1.w);
        if (WT8) { int w0 = 0, w1 = 0;
            w0 = __builtin_amdgcn_cvt_pk_fp8_f32(s[0 * 33] * WIN8_SCALE, s[1 * 33] * WIN8_SCALE, w0, false); w0 = __builtin_amdgcn_cvt_pk_fp8_f32(s[2 * 33] * WIN8_SCALE, s[3 * 33] * WIN8_SCALE, w0, true);
            w1 = __builtin_amdgcn_cvt_pk_fp8_f32(s[4 * 33] * WIN8_SCALE, s[5 * 33] * WIN8_SCALE, w1, false); w1 = __builtin_amdgcn_cvt_pk_fp8_f32(s[6 * 33] * WIN8_SCALE, s[7 * 33] * WIN8_SCALE, w1, true);
            if (n < ncols) *(GAS v2u*)(WT8 + (size_t)(dst_n0 + n) * K + k0 + 8 * c) = (v2u){(unsigned)w0, (unsigned)w1}; }
        else if (n < ncols) *(GAS v4u*)(WT + (size_t)(dst_n0 + n) * K + k0 + 8 * c) = o; }
    LDS_WAIT(); asm volatile("" ::: "memory");
}
__device__ __forceinline__ void rms_row_to_bf16(const float* xrow, const f32x4 (&gv)[8], bf16* orow, int lane, float* rms_out, unsigned char* orow8) {
    const GAS f32x4* xr = (const GAS f32x4*)xrow + lane;
    f32x4 v[8]; float s = 0.f;
#pragma unroll
    for (int j = 0; j < 8; ++j) { v[j] = xr[64 * j]; s += (v[j].x * v[j].x + v[j].y * v[j].y) + (v[j].z * v[j].z + v[j].w * v[j].w); }
    const float rstd = rsqrtf(wave_sum(s) * (1.f / DM) + EPS);
    if (lane == 0) *rms_out = 1.f / rstd;
    GAS v2u* o8 = (GAS v2u*)orow + lane;
#pragma unroll
    for (int j = 0; j < 8; ++j) { const f32x4 gg = gv[j];
        const float y0 = v[j].x * rstd * gg.x, y1 = v[j].y * rstd * gg.y, y2 = v[j].z * rstd * gg.z, y3 = v[j].w * rstd * gg.w;
        v2u o; o.x = pk2(y0, y1); o.y = pk2(y2, y3); o8[64 * j] = o;
        int w8 = 0; w8 = __builtin_amdgcn_cvt_pk_fp8_f32(y0, y1, w8, false); w8 = __builtin_amdgcn_cvt_pk_fp8_f32(y2, y3, w8, true);
        *(GAS unsigned*)(orow8 + 256 * j + 4 * lane) = (unsigned)w8; }
}

__device__ __forceinline__ void p0_prologue(Frame& F) {
    LAS float* scr = (LAS float*)(F.lds + RING_OFF + F.wave * 16384);
    const int gw = F.vcu * NWAVES + F.wave, NGW = F.G * NWAVES;
    const int gtid = F.vcu * (NWAVES * 64) + F.tid, NT = F.G * NWAVES * 64;
    constexpr int KB = DM / 64;
    constexpr int NB_IN = 160 + 32 + 1;
    constexpr int I_IN = KB * NB_IN, I_O = KB * (DM / 32), I_Q = KB * (DM / 32);
    for (int it = gw; it < I_IN + I_O + I_Q; it += NGW) {
        int r = it;
        if (r < I_IN) { const int kb = r / NB_IN, nb = r % NB_IN; int s0, d0, nc = 32;
            if (nb < 160) { s0 = 32 * nb; d0 = s0; } else if (nb < 192) { s0 = 5136 + 32 * (nb - 160); d0 = 5120 + 32 * (nb - 160); } else { s0 = 5120; d0 = 6144; nc = 16; }
            transpose_item(F.w_in, DM, DIN, F.WinT, s0, d0, nc, 64 * kb, scr, F.lane, nullptr, (nb < 192 && is_f8_col(d0)) ? F.WIN8 : nullptr); continue; }
        r -= I_IN;
        if (r < I_O) { const int kb = r / (DM / 32), nb = r % (DM / 32); transpose_item(F.w_out, DM, DM, F.WoutT, 32 * nb, 32 * nb, 32, 64 * kb, scr, F.lane); continue; }
        r -= I_O;
        { const int kb = r / (DM / 32), nb = r % (DM / 32); transpose_item(F.w_q, DM, DM, F.WqT, 32 * nb, 32 * nb, 32, 64 * kb, scr, F.lane, F.ln2g); }
    }
    f32x4 g2v[8];
#pragma unroll
    for (int j = 0; j < 8; ++j) g2v[j] = ((const GAS f32x4*)F.ln2g)[64 * j + F.lane];
    for (int row = gw; row < 2 * NEXP; row += NGW) {
        const bool isv = row >= NEXP; const int e = isv ? row - NEXP : row;
        const GAS f32x4* src = (const GAS f32x4*)((isv ? F.pv : F.pu) + (size_t)e * DM) + F.lane;
        f32x4 v[8]; float am = 0.f;
#pragma unroll
        for (int j = 0; j < 8; ++j) v[j] = src[64 * j];
#pragma unroll
        for (int j = 0; j < 8; ++j) { f32x4 t = v[j]; if (!isv) t = t * g2v[j];
            v[j] = t; am = fmaxf(am, fmaxf(fmaxf(fabsf(t.x), fabsf(t.y)), fmaxf(fabsf(t.z), fabsf(t.w)))); }
        am = wave_max(am);
        const float sc = fmaxf(am, 1e-30f) * (isv ? (1.f / 448.f) : (1.f / 127.f)), inv = 1.f / sc;
        unsigned char* tb = isv ? F.V8 : F.U8;
#pragma unroll
        for (int j = 0; j < 8; ++j) { const f32x4 t = v[j] * inv; int w = 0;
            if (isv) { w = __builtin_amdgcn_cvt_pk_fp8_f32(t.x, t.y, w, false); w = __builtin_amdgcn_cvt_pk_fp8_f32(t.z, t.w, w, true); }
            else w = (int)q8pack(t.x, t.y, t.z, t.w);
            *(GAS unsigned*)(tb + ((size_t)(2 * j + (F.lane >> 5)) * NEXP + e) * 128 + 4 * (F.lane & 31)) = (unsigned)w; }
        if (F.lane == 0) F.SC[row] = sc;
    }
    { f32x4 g1v[8];
#pragma unroll
      for (int j = 0; j < 8; ++j) g1v[j] = ((const GAS f32x4*)F.ln1g)[64 * j + F.lane];
      for (int m = gw; m < T; m += NGW) rms_row_to_bf16(F.x + (size_t)m * DM, g1v, F.XN + (size_t)m * DM, F.lane, F.RMS1 + m, F.XN8 + (size_t)m * DM); }
    for (int i = gtid; i < NH * SEQ; i += NT) {
        const int h = i >> 11, dist = i & 2047;
        const int cnt = (dist <= 128 ? 1 : 0) + (((dist & 3) == 0 && dist <= 512) ? 1 : 0) + (((dist & 15) == 0) ? 1 : 0);
        int bucket = dist;
        if (dist >= 16) { bucket = 16 + (int)(log((double)dist / 16.0) / log(128.0) * 16.0); if (bucket > 31) bucket = 31; }
        F.LB[i] = cnt ? F.rel_bias[bucket * NH + h] * LOG2E + log2f((float)cnt) : -1e30f;
    }
}

__device__ __forceinline__ void ga_mfma(Frame& F) {
    typedef float f32x4_t __attribute__((ext_vector_type(4)));
    const int gw = F.vcu * NWAVES + F.wave, NGW = F.G * NWAVES, lane = F.lane, r16 = lane & 15, kg = lane >> 4;
    for (int task = gw; task < T / 16; task += NGW) {
        const bf16* ap = F.XN + (size_t)(task * 16 + r16) * DM + 8 * kg;
        const bf16* bp = F.WinT + (size_t)(NPROJ + r16) * DM + 8 * kg;
        f32x4_t acc = {0.f, 0.f, 0.f, 0.f};
#pragma unroll 8
        for (int ks = 0; ks < DM / 32; ++ks) { const bf16x8 a = *(const GAS bf16x8*)(ap + 32 * ks), bb = *(const GAS bf16x8*)(bp + 32 * ks);
            acc = __builtin_amdgcn_mfma_f32_16x16x32_bf16(a, bb, acc, 0, 0, 0); }
#pragma unroll
        for (int r = 0; r < 4; ++r) F.GA[(size_t)(task * 16 + 4 * kg + r) * 16 + r16] = acc[r];
    }
}

namespace att {
typedef short s16x4 __attribute__((ext_vector_type(4)));
typedef short v4i16_t __attribute__((ext_vector_type(4)));
typedef float f32x16 __attribute__((ext_vector_type(16)));
typedef float f32x2_t __attribute__((ext_vector_type(2))); typedef __bf16 bf16x2_t __attribute__((ext_vector_type(2)));
__device__ __forceinline__ unsigned cvtpk(float lo, float hi) { f32x2_t v = {lo, hi}; bf16x2_t bb = __builtin_convertvector(v, bf16x2_t); return __builtin_bit_cast(unsigned, bb); }
__device__ __forceinline__ s16x4 vtr(const LAS unsigned char* p) { return __builtin_bit_cast(s16x4, __builtin_amdgcn_ds_read_tr16_b64_v4i16((LAS v4i16_t*)p)); }
__device__ __forceinline__ int crow(int r, int hi) { return (r & 3) + 8 * (r >> 2) + 4 * hi; }
constexpr int KST = 144, TILEB = 64 * KST;
constexpr int L_LB = 0, L_K = 9856, L_V = L_K + 2 * TILEB, L_WS = L_V + 2 * TILEB;
constexpr int N_UNITS = BATCH * NH * (SEQ / 256);
#define ATT_MFMA(a, b, c) __builtin_amdgcn_mfma_f32_32x32x16_bf16((a), (b), (c), 0, 0, 0)

__device__ __forceinline__ void attn_unit(Frame& F, int b, int hh, int qb) {
    LAS unsigned char* lds = F.lds;
    const int tid = F.tid, lane = F.lane, w = F.wave, r32 = lane & 31, hi = lane >> 5;
    const int q0 = qb * 256, NT = (q0 + 256) >> 6, nfar = qb > 2 ? qb - 2 : 0, kt0 = 4 * nfar;
    const int qposl = q0 + 2 * w + (r32 >> 4) + 16 * (r32 & 15);
    const size_t rowb = (size_t)b * SEQ;
    LAS float* LBs = (LAS float*)(lds + L_LB);
    __syncthreads();
    float lbv[5];
#pragma unroll
    for (int j = 0; j < 5; ++j) { const int i = tid + 512 * j; lbv[j] = (i >= 256 && i < 2304) ? F.LB[hh * SEQ + i - 256] : -1e30f; }
    bf16x8 qr[4];
    { const bf16* qp = F.PROJ + (rowb + qposl) * NPROJ + C_AQ + hh * 64 + hi * 8;
#pragma unroll
      for (int ks = 0; ks < 4; ++ks) qr[ks] = *(const GAS bf16x8*)(qp + 16 * ks); }
    const int srow = tid >> 3, sch = tid & 7;
    const bf16* kg = F.PROJ + (rowb + srow) * NPROJ + C_AK + hh * 64 + sch * 8;
    const bf16* vg = F.PROJ + (rowb + srow) * NPROJ + C_AV + hh * 64 + sch * 8;
    const int soff = srow * KST + sch * 16;
    v4u kreg = *(const GAS v4u*)(kg + (size_t)kt0 * 64 * NPROJ), vreg = *(const GAS v4u*)(vg + (size_t)kt0 * 64 * NPROJ);
    *(LAS v4u*)(lds + L_K + soff) = kreg; *(LAS v4u*)(lds + L_V + soff) = vreg;
#pragma unroll
    for (int j = 0; j < 5; ++j) { const int i = tid + 512 * j; if (i < 2304) LBs[i + (i >> 4)] = lbv[j]; }
    kreg = *(const GAS v4u*)(kg + (size_t)(kt0 + 1) * 64 * NPROJ); vreg = *(const GAS v4u*)(vg + (size_t)(kt0 + 1) * 64 * NPROJ);
    f32x16 o0, o1;
#pragma unroll
    for (int r = 0; r < 16; ++r) { o0[r] = 0.f; o1[r] = 0.f; }
    float mref = 0.f, l = 0.f;
    bool first = true;
    const int B0 = 256 + qposl - 4 * hi, nib = B0 & 15, Sd0 = B0 + (B0 >> 4);
    int bwm = 0;
#pragma unroll
    for (int mi = 0; mi < 8; ++mi) bwm |= ((nib < ((mi & 3) + 8 * (mi >> 2))) ? 1 : 0) << mi;
    const int bwf = (r32 >> 4) == 0 ? 1 : 0;
    LAS float* wsf = (LAS float*)(lds + L_WS + w * 256);
    LAS unsigned char* fv = lds + L_WS + 2048 + w * 4608;
    const int q4 = (lane & 15) >> 2, p4 = lane & 3, blk = (lane >> 4) & 1;
    const int voff = (4 * hi + q4) * KST + (16 * blk + 4 * p4) * 2;
    const int koff = r32 * KST + hi * 16;
    __syncthreads();
#pragma unroll 1
    for (int st = 0; st < nfar; ++st) {
        const int kb = 256 * st;
        bf16x8 ka[4]; v4u vv[4];
        { const bf16* kp = F.PROJ + (rowb + kb + 2 * w + (r32 >> 4) + 16 * (r32 & 15)) * NPROJ + C_AK + hh * 64 + hi * 8;
#pragma unroll
          for (int ks = 0; ks < 4; ++ks) ka[ks] = *(const GAS bf16x8*)(kp + 16 * ks);
          const int vr = lane >> 1, vh = lane & 1;
          const bf16* vpg = F.PROJ + (rowb + kb + 2 * w + (vr >> 4) + 16 * (vr & 15)) * NPROJ + C_AV + hh * 64 + 32 * vh;
#pragma unroll
          for (int i = 0; i < 4; ++i) vv[i] = *(const GAS v4u*)(vpg + 8 * i);
#pragma unroll
          for (int i = 0; i < 4; ++i) *(LAS v4u*)(fv + vr * KST + 64 * vh + 16 * i) = vv[i]; }
        f32x16 s0; const float ninit = -mref;
#pragma unroll
        for (int r = 0; r < 16; ++r) s0[r] = ninit;
#pragma unroll
        for (int ks = 0; ks < 4; ++ks) s0 = ATT_MFMA(ka[ks], qr[ks], s0);
        const int Bf = 256 + qposl - kb - 2 * w - 64 * hi; const LAS float* lbf = LBs + (Bf + (Bf >> 4));
        float tm = -3.0e38f;
        float bvf[16];
#pragma unroll
        for (int r = 0; r < 16; ++r) { const int off = (r >> 3) + 16 * (r & 3) + 128 * ((r >> 2) & 1); bvf[r] = lbf[-(off + (off >> 4)) - ((r >> 3) ? bwf : 0)]; }
        LDS_WAIT(); asm volatile("" ::: "memory");
#pragma unroll
        for (int r = 0; r < 16; ++r) { asm volatile("" : "+v"(bvf[r])); s0[r] += bvf[r]; tm = fmaxf(tm, s0[r]); }
        tm = fmaxf(tm, __shfl_xor(tm, 32));
        if (first || __any(tm > 8.f)) {
            const float d = first ? tm : fmaxf(tm, 0.f);
            mref += d; const float f = __builtin_amdgcn_exp2f(-d); l *= f;
#pragma unroll
            for (int r = 0; r < 16; ++r) s0[r] -= d;
            if (!first) {
                if (hi == 0) wsf[r32] = f;
                LDS_WAIT(); asm volatile("" ::: "memory");
#pragma unroll
                for (int r = 0; r < 16; ++r) { const float fr = wsf[crow(r, hi)]; o0[r] *= fr; o1[r] *= fr; }
                LDS_WAIT(); asm volatile("" ::: "memory");
            }
            first = false;
        }
        float ps = 0.f;
#pragma unroll
        for (int r = 0; r < 16; ++r) { s0[r] = __builtin_amdgcn_exp2f(s0[r]); ps += s0[r]; }
        l += ps;
        LDS_WAIT(); asm volatile("" ::: "memory");
#pragma unroll
        for (int s = 0; s < 2; ++s) {
            v4u pw; pw.x = cvtpk(s0[8 * s], s0[8 * s + 1]); pw.y = cvtpk(s0[8 * s + 2], s0[8 * s + 3]); pw.z = cvtpk(s0[8 * s + 4], s0[8 * s + 5]); pw.w = cvtpk(s0[8 * s + 6], s0[8 * s + 7]);
            const bf16x8 pa = __builtin_bit_cast(bf16x8, pw);
            const LAS unsigned char* vp = fv + voff + (16 * s) * KST;
            { const s16x4 lo = vtr(vp), hh2 = vtr(vp + 8 * KST); const bf16x8 vb = __builtin_shufflevector(lo, hh2, 0, 1, 2, 3, 4, 5, 6, 7); o0 = ATT_MFMA(pa, vb, o0); }
            { const s16x4 lo = vtr(vp + 64), hh2 = vtr(vp + 8 * KST + 64); const bf16x8 vb = __builtin_shufflevector(lo, hh2, 0, 1, 2, 3, 4, 5, 6, 7); o1 = ATT_MFMA(pa, vb, o1); }
        }
        LDS_WAIT(); asm volatile("" ::: "memory");
    }
    for (int kt = kt0; kt < NT; ++kt) {
        const int cur = kt & 1;
        {
            const LAS unsigned char* Kb = lds + L_K + cur * TILEB; const LAS unsigned char* Vb = lds + L_V + cur * TILEB;
            f32x16 s0, s1; const float ninit = -mref;
#pragma unroll
            for (int r = 0; r < 16; ++r) { s0[r] = ninit; s1[r] = ninit; }
#pragma unroll
            for (int ks = 0; ks < 4; ++ks) { const bf16x8 a0 = *(const LAS bf16x8*)(Kb + koff + ks * 32); const bf16x8 a1 = *(const LAS bf16x8*)(Kb + koff + 32 * KST + ks * 32);
                s0 = ATT_MFMA(a0, qr[ks], s0); s1 = ATT_MFMA(a1, qr[ks], s1); }
            const LAS float* lbp = LBs + (Sd0 - 68 * kt);
            float tm = -3.0e38f;
            float bv[16];
#pragma unroll
            for (int r = 0; r < 16; ++r) { const int c = (r & 3) + 8 * (r >> 2), mi = (r & 3) + 4 * ((r >> 2) & 1); bv[r] = lbp[-(c + (c >> 4)) - ((bwm >> mi) & 1)]; }
            LDS_WAIT(); asm volatile("" ::: "memory");
#pragma unroll
            for (int r = 0; r < 16; ++r) { asm volatile("" : "+v"(bv[r])); s0[r] += bv[r]; tm = fmaxf(tm, s0[r]); }
#pragma unroll
            for (int r = 0; r < 16; ++r) { const int c = (r & 3) + 8 * (r >> 2) + 32, mi = (r & 3) + 4 * ((r >> 2) & 1); bv[r] = lbp[-(c + (c >> 4)) - ((bwm >> mi) & 1)]; }
            LDS_WAIT(); asm volatile("" ::: "memory");
#pragma unroll
            for (int r = 0; r < 16; ++r) { asm volatile("" : "+v"(bv[r])); s1[r] += bv[r]; tm = fmaxf(tm, s1[r]); }
            tm = fmaxf(tm, __shfl_xor(tm, 32));
            if (first || __any(tm > 8.f)) {
                const float d = first ? tm : fmaxf(tm, 0.f);
                mref += d; const float f = __builtin_amdgcn_exp2f(-d); l *= f;
#pragma unroll
                for (int r = 0; r < 16; ++r) { s0[r] -= d; s1[r] -= d; }
                if (!first) {
                    if (hi == 0) wsf[r32] = f;
                    LDS_WAIT(); asm volatile("" ::: "memory");
#pragma unroll
                    for (int r = 0; r < 16; ++r) { const float fr = wsf[crow(r, hi)]; o0[r] *= fr; o1[r] *= fr; }
                    LDS_WAIT(); asm volatile("" ::: "memory");
                }
                first = false;
            }
            float ps = 0.f;
#pragma unroll
            for (int r = 0; r < 16; ++r) { s0[r] = __builtin_amdgcn_exp2f(s0[r]); s1[r] = __builtin_amdgcn_exp2f(s1[r]); ps += s0[r] + s1[r]; }
            l += ps;
#pragma unroll
            for (int mt = 0; mt < 2; ++mt)
#pragma unroll
                for (int s = 0; s < 2; ++s) {
                    v4u pw;
                    if (mt == 0) { pw.x = cvtpk(s0[8 * s], s0[8 * s + 1]); pw.y = cvtpk(s0[8 * s + 2], s0[8 * s + 3]); pw.z = cvtpk(s0[8 * s + 4], s0[8 * s + 5]); pw.w = cvtpk(s0[8 * s + 6], s0[8 * s + 7]); }
                    else { pw.x = cvtpk(s1[8 * s], s1[8 * s + 1]); pw.y = cvtpk(s1[8 * s + 2], s1[8 * s + 3]); pw.z = cvtpk(s1[8 * s + 4], s1[8 * s + 5]); pw.w = cvtpk(s1[8 * s + 6], s1[8 * s + 7]); }
                    const bf16x8 pa = __builtin_bit_cast(bf16x8, pw);
                    const LAS unsigned char* vp = Vb + voff + (32 * mt + 16 * s) * KST;
                    { const s16x4 lo = vtr(vp), hh2 = vtr(vp + 8 * KST); const bf16x8 vb = __builtin_shufflevector(lo, hh2, 0, 1, 2, 3, 4, 5, 6, 7); o0 = ATT_MFMA(pa, vb, o0); }
                    { const s16x4 lo = vtr(vp + 64), hh2 = vtr(vp + 8 * KST + 64); const bf16x8 vb = __builtin_shufflevector(lo, hh2, 0, 1, 2, 3, 4, 5, 6, 7); o1 = ATT_MFMA(pa, vb, o1); }
                }
        }
        if (kt + 1 < NT) {
            *(LAS v4u*)(lds + L_K + (cur ^ 1) * TILEB + soff) = kreg; *(LAS v4u*)(lds + L_V + (cur ^ 1) * TILEB + soff) = vreg;
            if (kt + 2 < NT) { kreg = *(const GAS v4u*)(kg + (size_t)(kt + 2) * 64 * NPROJ); vreg = *(const GAS v4u*)(vg + (size_t)(kt + 2) * 64 * NPROJ); }
        }
        __syncthreads();
    }
    { const float lt = l + __shfl_xor(l, 32); const float inv = 1.f / lt;
      if (hi == 0) wsf[r32] = inv;
      LDS_WAIT(); asm volatile("" ::: "memory");
      LAS unsigned char* ot = lds + L_K + w * 4608;
#pragma unroll
      for (int r = 0; r < 16; ++r) { const float fr = wsf[crow(r, hi)]; LAS unsigned short* orow_ = (LAS unsigned short*)(ot + crow(r, hi) * KST);
          orow_[r32] = (unsigned short)f2bf(o0[r] * fr); orow_[32 + r32] = (unsigned short)f2bf(o1[r] * fr); }
      LDS_WAIT(); asm volatile("" ::: "memory");
      { const int orw = lane >> 1, ohf = lane & 1; const LAS unsigned char* src = ot + orw * KST + 64 * ohf;
        bf16* op = F.MIX + (rowb + q0 + 2 * w + (orw >> 4) + 16 * (orw & 15)) * DM + hh * 64 + 32 * ohf;
        const v4u a0_ = *(const LAS v4u*)src, a1_ = *(const LAS v4u*)(src + 16), a2_ = *(const LAS v4u*)(src + 32), a3_ = *(const LAS v4u*)(src + 48);
        *(GAS v4u*)op = a0_; *(GAS v4u*)(op + 8) = a1_; *(GAS v4u*)(op + 16) = a2_; *(GAS v4u*)(op + 24) = a3_; }
      LDS_WAIT(); asm volatile("" ::: "memory"); }
}
template <class PostFn> __device__ __forceinline__ void attn_phase(Frame& F, gu32* qctr, int npre, PostFn post) {
    LAS int* uw = (LAS int*)(F.lds + 147456 - 1024);
    for (;;) {
        __syncthreads();
        if (F.tid == 0) *uw = (int)__hip_atomic_fetch_add(qctr, 1u, RLX_AGENT);
        __syncthreads();
        const int u0 = *uw;
        if (u0 >= npre + N_UNITS) break;
        if (u0 < npre) { post(u0); continue; }
        const int u = u0 - npre;
        const int qb = 7 - (u >> 7), bh = u & 127;
        attn_unit(F, bh >> 4, bh & 15, qb);
    }
}
}


namespace gla {
using att::f32x16; using att::s16x4; using att::vtr; using att::cvtpk; using att::crow;
constexpr int L_LA = 0;
constexpr int QST = 272;
constexpr int L_QT = 32768, L_QH = L_QT + 64 * QST, L_KH = L_QH + 64 * QST, L_KD = L_KH + 64 * QST;
constexpr int L_OST = L_QT, OSTF = 260;
constexpr int L_VS = 102400, VST = 528;
constexpr int L_SEG = 136192, L_DEC = L_SEG + 2048, L_GN = L_DEC + 512, L_END = L_GN + 1024;
constexpr int AST = 144;
#define GLA_MFMA(a, b, c) __builtin_amdgcn_mfma_f32_32x32x16_bf16((a), (b), (c), 0, 0, 0)
__device__ __forceinline__ bf16x8 pack8(const f32x16& x, int s) {
    v4u p; p.x = cvtpk(x[8 * s], x[8 * s + 1]); p.y = cvtpk(x[8 * s + 2], x[8 * s + 3]); p.z = cvtpk(x[8 * s + 4], x[8 * s + 5]); p.w = cvtpk(x[8 * s + 6], x[8 * s + 7]);
    return __builtin_bit_cast(bf16x8, p);
}
constexpr int REC_QT = 0, REC_AT = 64 * QST, REC_BYTES = REC_AT + 64 * AST;
constexpr size_t SCR_REC = 0, SCR_DEC = 28 * MiB, SCR_KV = 32 * MiB;
constexpr int NITEM = BATCH * NGH * (SEQ / 64);
constexpr int REC_PIECES = REC_BYTES / 16;
__device__ __forceinline__ void gla_pre_item(Frame& F, int b, int h, int n, int item) {
    LAS unsigned char* lds = F.lds;
    const int tid = F.tid, lane = F.lane, w = F.wave, r32 = lane & 31, hi = lane >> 5;
    const size_t rowb = (size_t)b * SEQ;
    const int gmt = w & 1, gnt = w >> 1;
    const int pt = tid >> 3, ps = tid & 7;
    LAS float* LA = (LAS float*)(lds + L_LA); LAS float* SEG = (LAS float*)(lds + L_SEG); LAS float* DEC = (LAS float*)(lds + L_DEC);
    bf16x8 wgf;
    { v4u t;
      t.x = pk2(F.wg2[(8 * hi + 0) * 512 + h * 128 + 32 * gnt + r32], F.wg2[(8 * hi + 1) * 512 + h * 128 + 32 * gnt + r32]);
      t.y = pk2(F.wg2[(8 * hi + 2) * 512 + h * 128 + 32 * gnt + r32], F.wg2[(8 * hi + 3) * 512 + h * 128 + 32 * gnt + r32]);
      t.z = pk2(F.wg2[(8 * hi + 4) * 512 + h * 128 + 32 * gnt + r32], F.wg2[(8 * hi + 5) * 512 + h * 128 + 32 * gnt + r32]);
      t.w = pk2(F.wg2[(8 * hi + 6) * 512 + h * 128 + 32 * gnt + r32], F.wg2[(8 * hi + 7) * 512 + h * 128 + 32 * gnt + r32]);
      wgf = __builtin_bit_cast(bf16x8, t); }
    const float gbias = F.bgate[h * 128 + 32 * gnt + r32];
    v4u pq[2], pk[2], pv[4]; f32x4 pga[2];
    { const float* ga_ = F.GA + (rowb + 64 * n + 32 * gmt + r32) * 16 + 8 * hi; pga[0] = *(const GAS f32x4*)ga_; pga[1] = *(const GAS f32x4*)(ga_ + 4);
      const bf16* pr_ = F.PROJ + (rowb + 64 * n + pt) * NPROJ;
      pq[0] = *(const GAS v4u*)(pr_ + C_GQ + h * 128 + 16 * ps); pq[1] = *(const GAS v4u*)(pr_ + C_GQ + h * 128 + 16 * ps + 8);
      pk[0] = *(const GAS v4u*)(pr_ + C_GK + h * 128 + 16 * ps); pk[1] = *(const GAS v4u*)(pr_ + C_GK + h * 128 + 16 * ps + 8);
#pragma unroll
      for (int i = 0; i < 4; ++i) pv[i] = *(const GAS v4u*)(pr_ + C_GV + h * 256 + 32 * ps + 8 * i); }
    { v4u ap; ap.x = pk2(pga[0].x, pga[0].y); ap.y = pk2(pga[0].z, pga[0].w); ap.z = pk2(pga[1].x, pga[1].y); ap.w = pk2(pga[1].z, pga[1].w);
      f32x16 z;
#pragma unroll
      for (int r = 0; r < 16; ++r) z[r] = 0.f;
      z = GLA_MFMA(__builtin_bit_cast(bf16x8, ap), wgf, z);
#pragma unroll
      for (int r = 0; r < 16; ++r) { float lg = z[r] + gbias; lg = fminf(fmaxf(lg, -80.f), 80.f);
          const float la2 = -__builtin_amdgcn_logf(1.f + __builtin_amdgcn_exp2f(-lg * LOG2E)) * (1.f / 16.f);
          LA[(32 * gmt + crow(r, hi)) * 128 + 32 * gnt + r32] = la2; } }
    __syncthreads();
    { const int c = tid & 127, seg = tid >> 7; float run = 0.f;
#pragma unroll
      for (int i = 0; i < 16; ++i) { run += LA[(16 * seg + i) * 128 + c]; LA[(16 * seg + i) * 128 + c] = run; }
      SEG[seg * 128 + c] = run; }
    __syncthreads();
    { const int c0 = 16 * ps, sg = pt >> 4;
      const int ro = pt * QST + c0 * 2;
#pragma unroll
      for (int i = 0; i < 4; ++i) {
          const f32x4 bb = *(const LAS f32x4*)(LA + pt * 128 + c0 + 4 * i);
          const f32x4 s0 = *(const LAS f32x4*)(SEG + c0 + 4 * i), s1 = *(const LAS f32x4*)(SEG + 128 + c0 + 4 * i), s2 = *(const LAS f32x4*)(SEG + 256 + c0 + 4 * i), s3 = *(const LAS f32x4*)(SEG + 384 + c0 + 4 * i);
          const f32x4 l31 = *(const LAS f32x4*)(LA + 31 * 128 + c0 + 4 * i);
          f32x4 pre = {0.f, 0.f, 0.f, 0.f}; if (sg > 0) pre += s0; if (sg > 1) pre += s1; if (sg > 2) pre += s2;
          const f32x4 bv = bb + pre, bref = l31 + s0, blast = (s0 + s1) + (s2 + s3);
          const unsigned qw0_ = (i < 2) ? (i == 0 ? pq[0].x : pq[0].z) : (i == 2 ? pq[1].x : pq[1].z), qw1_ = (i < 2) ? (i == 0 ? pq[0].y : pq[0].w) : (i == 2 ? pq[1].y : pq[1].w);
          const unsigned kw0_ = (i < 2) ? (i == 0 ? pk[0].x : pk[0].z) : (i == 2 ? pk[1].x : pk[1].z), kw1_ = (i < 2) ? (i == 0 ? pk[0].y : pk[0].w) : (i == 2 ? pk[1].y : pk[1].w);
          const float qv[4] = {bflo(qw0_) * GQSCALE, bfhi(qw0_) * GQSCALE, bflo(qw1_) * GQSCALE, bfhi(qw1_) * GQSCALE};
          const float kv[4] = {bflo(kw0_), bfhi(kw0_), bflo(kw1_), bfhi(kw1_)};
          float a_[4], b_[4], c_[4], d_[4];
#pragma unroll
          for (int e = 0; e < 4; ++e) { const float eb = __builtin_amdgcn_exp2f(bv[e]), e1 = __builtin_amdgcn_exp2f(bv[e] - bref[e]), e2 = __builtin_amdgcn_exp2f(bref[e] - bv[e]), e3 = __builtin_amdgcn_exp2f(blast[e] - bv[e]);
              a_[e] = qv[e] * eb; b_[e] = qv[e] * e1; c_[e] = kv[e] * e2; d_[e] = kv[e] * e3; }
          *(LAS v2u*)(lds + L_QT + ro + 8 * i) = (v2u){cvtpk(a_[0], a_[1]), cvtpk(a_[2], a_[3])}; *(LAS v2u*)(lds + L_QH + ro + 8 * i) = (v2u){cvtpk(b_[0], b_[1]), cvtpk(b_[2], b_[3])};
          *(LAS v2u*)(lds + L_KH + ro + 8 * i) = (v2u){cvtpk(c_[0], c_[1]), cvtpk(c_[2], c_[3])}; *(LAS v2u*)(lds + L_KD + ro + 8 * i) = (v2u){cvtpk(d_[0], d_[1]), cvtpk(d_[2], d_[3])};
          __builtin_amdgcn_sched_barrier(0);
          if (pt == 0) { f32x4 dv; dv.x = __builtin_amdgcn_exp2f(blast.x); dv.y = __builtin_amdgcn_exp2f(blast.y); dv.z = __builtin_amdgcn_exp2f(blast.z); dv.w = __builtin_amdgcn_exp2f(blast.w); *(LAS f32x4*)(DEC + c0 + 4 * i) = dv; }
      }
#pragma unroll
      for (int i = 0; i < 4; ++i) *(LAS v4u*)(lds + L_VS + pt * VST + 64 * ps + 16 * i) = pv[i]; }
    __syncthreads();
    if (w < 3) { const int jt = (w == 2) ? 1 : 0, it = (w >= 1) ? 1 : 0;
        f32x16 x;
#pragma unroll
        for (int r = 0; r < 16; ++r) x[r] = 0.f;
#pragma unroll
        for (int ks = 0; ks < 8; ++ks) { const bf16x8 a = *(const LAS bf16x8*)(lds + L_KH + (32 * jt + r32) * QST + (16 * ks + 8 * hi) * 2);
            const bf16x8 bq = *(const LAS bf16x8*)(lds + L_QH + (32 * it + r32) * QST + (16 * ks + 8 * hi) * 2); x = GLA_MFMA(a, bq, x); }
        const int i = 32 * it + r32;
#pragma unroll
        for (int g = 0; g < 4; ++g) { const int j0 = 32 * jt + 8 * g + 4 * hi;
            const float v0 = (j0 + 0 <= i) ? x[4 * g + 0] : 0.f, v1 = (j0 + 1 <= i) ? x[4 * g + 1] : 0.f, v2 = (j0 + 2 <= i) ? x[4 * g + 2] : 0.f, v3 = (j0 + 3 <= i) ? x[4 * g + 3] : 0.f;
            v2u pw; pw.x = cvtpk(v0, v1); pw.y = cvtpk(v2, v3); *(LAS v2u*)(lds + L_LA + i * AST + j0 * 2) = pw; }
    } else if (w == 3) { const v4u zz = {0u, 0u, 0u, 0u}; *(LAS v4u*)(lds + L_LA + r32 * AST + 64 + hi * 32) = zz; *(LAS v4u*)(lds + L_LA + r32 * AST + 64 + hi * 32 + 16) = zz; }
    __syncthreads();
    { const int q4 = (lane & 15) >> 2, p4 = lane & 3, blk = (lane >> 4) & 1;
      unsigned char* kvp = (unsigned char*)F.out + SCR_KV + (size_t)item * (256 * 128 * 2) + (size_t)(32 * w + r32) * 256;
      bf16x8 vf[4];
#pragma unroll
      for (int s = 0; s < 4; ++s) { const LAS unsigned char* vp_ = lds + L_VS + (16 * s + 8 * hi + q4) * VST + (32 * w + 16 * blk + 4 * p4) * 2; const s16x4 lo_ = vtr(vp_), hi_ = vtr(vp_ + 4 * VST); vf[s] = __builtin_shufflevector(lo_, hi_, 0, 1, 2, 3, 4, 5, 6, 7); }
#pragma unroll
      for (int ct = 0; ct < 4; ++ct) { f32x16 acc;
#pragma unroll
          for (int r = 0; r < 16; ++r) acc[r] = 0.f;
#pragma unroll
          for (int s = 0; s < 4; ++s) { const LAS unsigned char* kp = lds + L_KD + (16 * s + 8 * hi + q4) * QST + (32 * ct + 16 * blk + 4 * p4) * 2;
              const s16x4 lo = vtr(kp), hh2 = vtr(kp + 4 * QST); const bf16x8 af = __builtin_shufflevector(lo, hh2, 0, 1, 2, 3, 4, 5, 6, 7); acc = GLA_MFMA(af, vf[s], acc); }
#pragma unroll
          for (int g = 0; g < 4; ++g) { v2u pw; pw.x = cvtpk(acc[4 * g], acc[4 * g + 1]); pw.y = cvtpk(acc[4 * g + 2], acc[4 * g + 3]); *(GAS v2u*)(kvp + (32 * ct + 8 * g + 4 * hi) * 2) = pw; } } }
    { unsigned char* rec = (unsigned char*)F.out + SCR_REC + (size_t)item * REC_BYTES;
      for (int p = tid; p < REC_BYTES / 16; p += 512) { const int off = p * 16; const int src = off < REC_AT ? (L_QT + off) : (L_LA + off - REC_AT); *(GAS v4u*)(rec + off) = *(const LAS v4u*)(lds + src); }
      if (tid < 32) *(GAS f32x4*)((unsigned char*)F.out + SCR_DEC + (size_t)item * 512 + tid * 16) = *(const LAS f32x4*)(lds + L_DEC + tid * 16); }
    __syncthreads();
}
__device__ __forceinline__ void gla_scan(Frame& F) {
#pragma unroll 1
    for (int g = F.vcu * (NWAVES * 64) + F.tid; g < BATCH * NGH * 4096; g += F.G * NWAVES * 64) {
        const int bh = g >> 12, piece = g & 4095, c8 = (piece & 15) * 8;
        unsigned char* kv = (unsigned char*)F.out + SCR_KV + (size_t)bh * (SEQ / 64) * (256 * 128 * 2) + (size_t)piece * 16;
        const unsigned char* dc = (const unsigned char*)F.out + SCR_DEC + (size_t)bh * (SEQ / 64) * 512 + c8 * 4;
        float st[8];
#pragma unroll
        for (int j = 0; j < 8; ++j) st[j] = 0.f;
#pragma unroll 8
        for (int n = 0; n < SEQ / 64; ++n) {
            const v4u kw = *(const GAS v4u*)(kv + (size_t)n * (256 * 128 * 2));
            const f32x4 d0 = *(const GAS f32x4*)(dc + n * 512), d1 = *(const GAS f32x4*)(dc + n * 512 + 16);
            v4u ow; ow.x = cvtpk(st[0], st[1]); ow.y = cvtpk(st[2], st[3]); ow.z = cvtpk(st[4], st[5]); ow.w = cvtpk(st[6], st[7]);
            *(GAS v4u*)(kv + (size_t)n * (256 * 128 * 2)) = ow;
            st[0] = d0.x * st[0] + bflo(kw.x); st[1] = d0.y * st[1] + bfhi(kw.x); st[2] = d0.z * st[2] + bflo(kw.y); st[3] = d0.w * st[3] + bfhi(kw.y);
            st[4] = d1.x * st[4] + bflo(kw.z); st[5] = d1.y * st[5] + bfhi(kw.z); st[6] = d1.z * st[6] + bflo(kw.w); st[7] = d1.w * st[7] + bfhi(kw.w);
        }
    }
}
constexpr int P_REC = 0, P_VS = REC_BYTES, P_OST = P_VS + 64 * VST, P_GN = P_OST + 64 * OSTF * 4, P_END = P_GN + 1024;
__device__ __forceinline__ void gla_post_item(Frame& F, int b, int h, int n, int item) {
    LAS unsigned char* lds = F.lds;
    const int tid = F.tid, lane = F.lane, w = F.wave, r32 = lane & 31, hi = lane >> 5, q4 = (lane & 15) >> 2, p4 = lane & 3, blk = (lane >> 4) & 1, pt = tid >> 3, ps = tid & 7;
    const size_t rowb = (size_t)b * SEQ;
    LAS float* OST = (LAS float*)(lds + P_OST);
    __syncthreads();
    bf16x8 sf[8];
    { const unsigned char* sp = (const unsigned char*)F.out + SCR_KV + (size_t)item * (256 * 128 * 2) + (size_t)(32 * w + r32) * 256 + 16 * hi;
#pragma unroll
      for (int ks = 0; ks < 8; ++ks) sf[ks] = *(const GAS bf16x8*)(sp + 32 * ks); }
    { const unsigned char* rec = (const unsigned char*)F.out + SCR_REC + (size_t)item * REC_BYTES;
      v4u rc_[4];
#pragma unroll
      for (int k = 0; k < 4; ++k) { const int p = tid + 512 * k; rc_[k] = (p < REC_BYTES / 16) ? *(const GAS v4u*)(rec + p * 16) : (v4u){0u, 0u, 0u, 0u}; }
#pragma unroll
      for (int k = 0; k < 4; ++k) { const int p = tid + 512 * k; if (p < REC_BYTES / 16) *(LAS v4u*)(lds + P_REC + p * 16) = rc_[k]; }
      const bf16* pr_ = F.PROJ + (rowb + 64 * n + pt) * NPROJ;
#pragma unroll
      for (int i = 0; i < 4; ++i) *(LAS v4u*)(lds + P_VS + pt * VST + 64 * ps + 16 * i) = *(const GAS v4u*)(pr_ + C_GV + h * 256 + 32 * ps + 8 * i);
      if (tid < 256) ((LAS float*)(lds + P_GN))[tid] = F.gng[h * 256 + tid]; }
    v4u gr_[4];
    { const bf16* pr_ = F.PROJ + (rowb + 64 * n + pt) * NPROJ + C_GR + h * 256 + 32 * ps;
#pragma unroll
      for (int i = 0; i < 4; ++i) gr_[i] = *(const GAS v4u*)(pr_ + 8 * i); }
    __syncthreads();
    f32x16 o0, o1;
#pragma unroll
    for (int r = 0; r < 16; ++r) { o0[r] = 0.f; o1[r] = 0.f; }
#pragma unroll
    for (int ks = 0; ks < 8; ++ks) {
        const bf16x8 a0 = *(const LAS bf16x8*)(lds + P_REC + REC_QT + r32 * QST + (16 * ks + 8 * hi) * 2), a1 = *(const LAS bf16x8*)(lds + P_REC + REC_QT + (32 + r32) * QST + (16 * ks + 8 * hi) * 2);
        o0 = GLA_MFMA(a0, sf[ks], o0); o1 = GLA_MFMA(a1, sf[ks], o1); }
#pragma unroll
    for (int s = 0; s < 4; ++s) {
        const LAS unsigned char* vp_ = lds + P_VS + (16 * s + 8 * hi + q4) * VST + (32 * w + 16 * blk + 4 * p4) * 2; const s16x4 lo_ = vtr(vp_), hi_ = vtr(vp_ + 4 * VST);
        const bf16x8 vf = __builtin_shufflevector(lo_, hi_, 0, 1, 2, 3, 4, 5, 6, 7);
        if (s < 2) { const bf16x8 a = *(const LAS bf16x8*)(lds + P_REC + REC_AT + r32 * AST + (16 * s + 8 * hi) * 2); o0 = GLA_MFMA(a, vf, o0); }
        { const bf16x8 a = *(const LAS bf16x8*)(lds + P_REC + REC_AT + (32 + r32) * AST + (16 * s + 8 * hi) * 2); o1 = GLA_MFMA(a, vf, o1); }
    }
#pragma unroll
    for (int r = 0; r < 16; ++r) { OST[crow(r, hi) * OSTF + 32 * w + r32] = o0[r]; OST[(32 + crow(r, hi)) * OSTF + 32 * w + r32] = o1[r]; }
    __syncthreads();
    { f32x4 ov[8]; float ss = 0.f;
#pragma unroll
      for (int i = 0; i < 8; ++i) { ov[i] = *(const LAS f32x4*)(OST + pt * OSTF + 32 * ps + 4 * i); ss += (ov[i].x * ov[i].x + ov[i].y * ov[i].y) + (ov[i].z * ov[i].z + ov[i].w * ov[i].w); }
      ss += __shfl_xor(ss, 1); ss += __shfl_xor(ss, 2); ss += __shfl_xor(ss, 4);
      const float rstd = rsqrtf(ss * (1.f / 256.f) + EPS);
      bf16* op = F.MIX + (rowb + 64 * n + pt) * DM + 1024 + h * 256 + 32 * ps;
      const LAS float* gp = (const LAS float*)(lds + P_GN) + 32 * ps;
#pragma unroll
      for (int i = 0; i < 4; ++i) { const f32x4 g0 = *(const LAS f32x4*)(gp + 8 * i), g1 = *(const LAS f32x4*)(gp + 8 * i + 4); const v4u gw = gr_[i];
          float y[8]; const float grv[8] = {bflo(gw.x), bfhi(gw.x), bflo(gw.y), bfhi(gw.y), bflo(gw.z), bfhi(gw.z), bflo(gw.w), bfhi(gw.w)};
          const float ovv[8] = {ov[2 * i].x, ov[2 * i].y, ov[2 * i].z, ov[2 * i].w, ov[2 * i + 1].x, ov[2 * i + 1].y, ov[2 * i + 1].z, ov[2 * i + 1].w};
          const float gg[8] = {g0.x, g0.y, g0.z, g0.w, g1.x, g1.y, g1.z, g1.w};
#pragma unroll
          for (int e = 0; e < 8; ++e) { const float sil = grv[e] * __builtin_amdgcn_rcpf(1.f + __builtin_amdgcn_exp2f(-grv[e] * LOG2E)); y[e] = ovv[e] * rstd * gg[e] * sil; }
          v4u ow; ow.x = cvtpk(y[0], y[1]); ow.y = cvtpk(y[2], y[3]); ow.z = cvtpk(y[4], y[5]); ow.w = cvtpk(y[6], y[7]);
          *(GAS v4u*)(op + 8 * i) = ow; } }
}
}

namespace pks {
using att::f32x16; using att::crow;
constexpr int KROW = 272;
constexpr int L_K1 = 0, L_K2 = 128 * KROW, L_TAB = 2 * 128 * KROW;
#define PK_MFMA(a, b, c) __builtin_amdgcn_mfma_f32_32x32x16_bf16((a), (b), (c), 0, 0, 0)
#define PK_CE(a, b) do { const float hi_ = fmaxf((a), (b)), lo_ = fminf((a), (b)); (a) = hi_; (b) = lo_; } while (0)
__device__ __forceinline__ void sort16(float (&x)[16]) {
#pragma unroll
    for (int k = 2; k <= 16; k <<= 1)
#pragma unroll
        for (int j = k >> 1; j > 0; j >>= 1)
#pragma unroll
            for (int i = 0; i < 16; ++i) { const int l = i ^ j; if (l > i) { if ((i & k) == 0) PK_CE(x[i], x[l]); else PK_CE(x[l], x[i]); } }
}
__device__ __forceinline__ void merge16(float (&t)[16], const float (&g)[16]) {
#pragma unroll
    for (int i = 0; i < 16; ++i) t[i] = fmaxf(t[i], g[15 - i]);
#pragma unroll
    for (int j = 8; j > 0; j >>= 1)
#pragma unroll
        for (int i = 0; i < 16; ++i) { const int l = i ^ j; if (l > i) PK_CE(t[i], t[l]); }
}
__device__ __forceinline__ float packid(float v, unsigned id, unsigned mask) { return __builtin_bit_cast(float, (__builtin_bit_cast(unsigned, v) & ~mask) | id); }
__device__ __forceinline__ float clearid(float v, unsigned mask) { return __builtin_bit_cast(float, __builtin_bit_cast(unsigned, v) & ~mask); }
__device__ __forceinline__ void set_top16(Frame& F, const bf16* qbase, int ktab, float (&T)[16], int lane) {
    const int r32 = lane & 31, hi = lane >> 5;
    f32x16 acc[4];
#pragma unroll
    for (int mt = 0; mt < 4; ++mt)
#pragma unroll
        for (int r = 0; r < 16; ++r) acc[mt][r] = 0.f;
#pragma unroll
    for (int ks = 0; ks < 8; ++ks) {
        const bf16x8 qf = *(const GAS bf16x8*)(qbase + 16 * ks + 8 * hi);
#pragma unroll
        for (int mt = 0; mt < 4; ++mt) { const bf16x8 kf = *(const LAS bf16x8*)(F.lds + ktab + (32 * mt + r32) * KROW + (16 * ks + 8 * hi) * 2); acc[mt] = PK_MFMA(kf, qf, acc[mt]); }
    }
    float g[16];
#pragma unroll
    for (int mt = 0; mt < 4; ++mt) {
#pragma unroll
        for (int r = 0; r < 16; ++r) g[r] = packid(acc[mt][r], (unsigned)(32 * mt + crow(r, hi)), 127u);
        sort16(g);
        if (mt == 0) {
#pragma unroll
            for (int r = 0; r < 16; ++r) T[r] = g[r];
        } else merge16(T, g);
    }
#pragma unroll
    for (int r = 0; r < 16; ++r) g[r] = __shfl_xor(T[r], 32);
    merge16(T, g);
}
__device__ __forceinline__ void peer_score(Frame& F) {
    const int tid = F.tid, lane = F.lane, w = F.wave, r32 = lane & 31, hi = lane >> 5;
    { f32x4 kv_[16];
#pragma unroll
      for (int j = 0; j < 16; ++j) { const int i = tid + 512 * j, s = i >> 12, row = (i >> 5) & 127, c4 = i & 31; kv_[j] = *(const GAS f32x4*)((s ? F.keys2 : F.keys1) + row * 128 + 4 * c4); }
#pragma unroll
      for (int j = 0; j < 16; ++j) { const int i = tid + 512 * j, s = i >> 12, row = (i >> 5) & 127, c4 = i & 31; const f32x4 v = kv_[j];
        v2u o; o.x = pk2(v.x, v.y); o.y = pk2(v.z, v.w); *(LAS v2u*)(F.lds + (s ? L_K2 : L_K1) + row * KROW + 8 * c4) = o; } }
    __syncthreads();
    LAS unsigned char* tab = F.lds + L_TAB + w * 2304 + lane * 36;
    const float NEG = -3.0e38f;
    for (int task = 2 * (int)blockIdx.x * PEH + w; task < (T / 32) * PEH; task += (task & 8) ? (2 * F.G - 1) * PEH : PEH) {
        const int tg = task >> 3, hp = task & 7; const int m = tg * 32 + r32;
        const bf16* q = F.PQ + (size_t)m * DM + hp * 256;
        float rstd;
        { float s_ = 0.f;
#pragma unroll
          for (int k = 0; k < 16; ++k) s_ += F.SSQ[(size_t)(16 * hi + k) * T + m];
          s_ += __shfl_xor(s_, 32); rstd = rsqrtf(s_ * (1.f / DM) + EPS); if (hp == 0 && hi == 0) F.RSTD[m] = rstd; }
        float T1[16], T2[16];
        set_top16(F, q, L_K1, T1, lane);
        set_top16(F, q + 128, L_K2, T2, lane);
        { v4u a, c;
          a.x = (__builtin_bit_cast(unsigned, T1[0]) & 127u) | ((__builtin_bit_cast(unsigned, T1[1]) & 127u) << 8) | ((__builtin_bit_cast(unsigned, T1[2]) & 127u) << 16) | ((__builtin_bit_cast(unsigned, T1[3]) & 127u) << 24);
          a.y = (__builtin_bit_cast(unsigned, T1[4]) & 127u) | ((__builtin_bit_cast(unsigned, T1[5]) & 127u) << 8) | ((__builtin_bit_cast(unsigned, T1[6]) & 127u) << 16) | ((__builtin_bit_cast(unsigned, T1[7]) & 127u) << 24);
          a.z = (__builtin_bit_cast(unsigned, T1[8]) & 127u) | ((__builtin_bit_cast(unsigned, T1[9]) & 127u) << 8) | ((__builtin_bit_cast(unsigned, T1[10]) & 127u) << 16) | ((__builtin_bit_cast(unsigned, T1[11]) & 127u) << 24);
          a.w = (__builtin_bit_cast(unsigned, T1[12]) & 127u) | ((__builtin_bit_cast(unsigned, T1[13]) & 127u) << 8) | ((__builtin_bit_cast(unsigned, T1[14]) & 127u) << 16) | ((__builtin_bit_cast(unsigned, T1[15]) & 127u) << 24);
          c.x = (__builtin_bit_cast(unsigned, T2[0]) & 127u) | ((__builtin_bit_cast(unsigned, T2[1]) & 127u) << 8) | ((__builtin_bit_cast(unsigned, T2[2]) & 127u) << 16) | ((__builtin_bit_cast(unsigned, T2[3]) & 127u) << 24);
          c.y = (__builtin_bit_cast(unsigned, T2[4]) & 127u) | ((__builtin_bit_cast(unsigned, T2[5]) & 127u) << 8) | ((__builtin_bit_cast(unsigned, T2[6]) & 127u) << 16) | ((__builtin_bit_cast(unsigned, T2[7]) & 127u) << 24);
          c.z = (__builtin_bit_cast(unsigned, T2[8]) & 127u) | ((__builtin_bit_cast(unsigned, T2[9]) & 127u) << 8) | ((__builtin_bit_cast(unsigned, T2[10]) & 127u) << 16) | ((__builtin_bit_cast(unsigned, T2[11]) & 127u) << 24);
          c.w = (__builtin_bit_cast(unsigned, T2[12]) & 127u) | ((__builtin_bit_cast(unsigned, T2[13]) & 127u) << 8) | ((__builtin_bit_cast(unsigned, T2[14]) & 127u) << 16) | ((__builtin_bit_cast(unsigned, T2[15]) & 127u) << 24);
          LAS unsigned* tw = (LAS unsigned*)tab;
          tw[0] = a.x; tw[1] = a.y; tw[2] = a.z; tw[3] = a.w; tw[4] = c.x; tw[5] = c.y; tw[6] = c.z; tw[7] = c.w; }
        float a_[16], b_[16];
#pragma unroll
        for (int i = 0; i < 16; ++i) { a_[i] = clearid(T1[i], 127u); b_[i] = clearid(T2[i], 127u); }
        float C[16], G[16];
#pragma unroll
        for (int j = 0; j < 16; ++j) C[j] = packid(a_[0] + b_[j], (unsigned)j, 255u);
        { int n = 0;
#pragma unroll
          for (int j = 0; j < 8; ++j) G[n++] = packid(a_[1] + b_[j], 16u + j, 255u);
#pragma unroll
          for (int j = 0; j < 5; ++j) G[n++] = packid(a_[2] + b_[j], 32u + j, 255u);
#pragma unroll
          for (int j = 0; j < 3; ++j) G[n++] = packid(a_[3] + b_[j], 48u + j, 255u);
          sort16(G); merge16(C, G); }
        { int n = 0;
          G[n++] = packid(a_[3] + b_[3], 48u + 3u, 255u);
#pragma unroll
          for (int j = 0; j < 3; ++j) G[n++] = packid(a_[4] + b_[j], 64u + j, 255u);
#pragma unroll
          for (int i = 5; i < 8; ++i) { G[n++] = packid(a_[i] + b_[0], 16u * i, 255u); G[n++] = packid(a_[i] + b_[1], 16u * i + 1u, 255u); }
#pragma unroll
          for (int i = 8; i < 14; ++i) G[n++] = packid(a_[i] + b_[0], 16u * i, 255u);
          sort16(G); merge16(C, G); }
        {
          G[0] = packid(a_[14] + b_[0], 16u * 14u, 255u); G[1] = packid(a_[15] + b_[0], 16u * 15u, 255u); if (G[1] > G[0]) { const float t_ = G[0]; G[0] = G[1]; G[1] = t_; }
#pragma unroll
          for (int i = 2; i < 16; ++i) G[i] = NEG;
          merge16(C, G); }
        const float mx = clearid(C[0], 255u);
        float e[16], sum = 0.f;
#pragma unroll
        for (int k = 0; k < 16; ++k) { e[k] = __builtin_amdgcn_exp2f((clearid(C[k], 255u) - mx) * (LOG2E * rstd)); sum += e[k]; }
        const float inv = 1.f / sum;
        LDS_WAIT(); asm volatile("" ::: "memory");
        int eo[8]; float go[8];
        { int k1_[8], k2_[8];
#pragma unroll
          for (int kk = 0; kk < 8; ++kk) { const float cv = hi ? C[8 + kk] : C[kk]; const unsigned id = __builtin_bit_cast(unsigned, cv) & 255u; k1_[kk] = tab[id >> 4]; k2_[kk] = tab[16 + (id & 15)]; }
          LDS_WAIT(); asm volatile("" ::: "memory");
#pragma unroll
          for (int kk = 0; kk < 8; ++kk) { asm volatile("" : "+v"(k1_[kk]), "+v"(k2_[kk])); eo[kk] = k1_[kk] * PEK + k2_[kk]; go[kk] = (hi ? e[8 + kk] : e[kk]) * inv; } }
        int* ip = F.IDX + (size_t)m * 128 + hp * 16 + 8 * hi; float* gp = F.GATE + (size_t)m * 128 + hp * 16 + 8 * hi;
        *(GAS v4u*)ip = (v4u){(unsigned)eo[0], (unsigned)eo[1], (unsigned)eo[2], (unsigned)eo[3]}; *(GAS v4u*)(ip + 4) = (v4u){(unsigned)eo[4], (unsigned)eo[5], (unsigned)eo[6], (unsigned)eo[7]};
        *(GAS f32x4*)gp = (f32x4){go[0], go[1], go[2], go[3]}; *(GAS f32x4*)(gp + 4) = (f32x4){go[4], go[5], go[6], go[7]};
        LDS_WAIT(); asm volatile("" ::: "memory");
    }
}
}

typedef float f32x2 __attribute__((ext_vector_type(2)));
__device__ __forceinline__ float gelu_erf(float v) {
    const float av = fabsf(v), t = __builtin_amdgcn_rcpf(av * 0.2316418882f + 1.0f);
    float q = t * 0.5307027145f + (-0.7265760135f); q = q * t + 0.7107068705f; q = q * t + (-0.142248368f); q = q * t + 0.127414796f; q = q * t;
    const float e = __builtin_amdgcn_exp2f((v * v) * (-0.72134752044f));
    const float mm = v * (q * e);
    return v < 0.f ? mm : v - mm;
}
namespace pex {
constexpr int L_IDX = 0, L_H = 32768, L_SS = 65536, L_RS = 81920, L_XS = 82176;
#define PX_DPP(v, ctrl) __builtin_bit_cast(float, __builtin_amdgcn_update_dpp(0, __builtin_bit_cast(int, (v)), (ctrl), 0xF, 0xF, true))
__device__ __forceinline__ float red8(float v) { v += PX_DPP(v, 0xB1); v += PX_DPP(v, 0x4E); v += PX_DPP(v, 0x141); return v; }
__device__ __forceinline__ float redpg(float v) {
    v += PX_DPP(v, 0x128); v += __shfl_xor(v, 16); v += __shfl_xor(v, 32);
    return v;
}
#define PX_CVT(w_, hi_) __builtin_amdgcn_cvt_pk_f32_fp8((int)(w_), (hi_))
__device__ __forceinline__ void peer_experts(Frame& F) {
    const int tid = F.tid, lane = F.lane, w = F.wave, seg = lane & 7, pg = lane >> 3;
    LAS unsigned* IDX2 = (LAS unsigned*)(F.lds + L_IDX); LAS float* H2 = (LAS float*)(F.lds + L_H); LAS float* SSL = (LAS float*)(F.lds + L_SS); LAS float* RSL = (LAS float*)(F.lds + L_RS);
    const bf16* HN = F.HN;
    for (int tile = (int)blockIdx.x; tile < T / 64; tile += F.G) {
        const int m0 = tile * 64;
        for (int i = tid; i < 64 * 64; i += 512) SSL[i] = 0.f;
        { int iv_[16];
#pragma unroll
          for (int j = 0; j < 16; ++j) iv_[j] = F.IDX[(size_t)m0 * 128 + tid + 512 * j];
#pragma unroll
          for (int j = 0; j < 16; ++j) { const int i = tid + 512 * j, t = i >> 7, p = i & 127; IDX2[t * 128 + (p & 7) * 16 + (p >> 3)] = (unsigned)iv_[j] * 128u; } }
        if (tid < 64) RSL[tid] = F.RSTD[m0 + tid];
        { LAS float* XSL = (LAS float*)(F.lds + L_XS);
#pragma unroll 1
          for (int hb = 0; hb < 2; ++hb) {
            v4u rw[4][4];
#pragma unroll
            for (int t4 = 0; t4 < 4; ++t4)
#pragma unroll
                for (int i = 0; i < 4; ++i) rw[t4][i] = *(const GAS v4u*)((const unsigned char*)(HN + (size_t)(m0 + 8 * w + 4 * hb + t4) * DM) + 64 * lane + 16 * i);
#pragma unroll
            for (int t4 = 0; t4 < 4; ++t4) { float am = 0.f;
#pragma unroll
                for (int i = 0; i < 4; ++i) { const v4u q = rw[t4][i];
                    am = fmaxf(am, fmaxf(fmaxf(fmaxf(fabsf(bflo(q.x)), fabsf(bfhi(q.x))), fmaxf(fabsf(bflo(q.y)), fabsf(bfhi(q.y)))), fmaxf(fmaxf(fabsf(bflo(q.z)), fabsf(bfhi(q.z))), fmaxf(fabsf(bflo(q.w)), fabsf(bfhi(q.w)))))); }
                am = wave_max(am);
                const float xs = fmaxf(am, 1e-30f) * (1.f / 127.f), xi = 1.f / xs;
                v4u o[2];
#pragma unroll
                for (int i = 0; i < 4; ++i) { const v4u q = rw[t4][i];
                    const unsigned lo = q8pack(bflo(q.x) * xi, bfhi(q.x) * xi, bflo(q.y) * xi, bfhi(q.y) * xi), hi2 = q8pack(bflo(q.z) * xi, bfhi(q.z) * xi, bflo(q.w) * xi, bfhi(q.w) * xi);
                    if (i == 0) { o[0].x = lo; o[0].y = hi2; } else if (i == 1) { o[0].z = lo; o[0].w = hi2; } else if (i == 2) { o[1].x = lo; o[1].y = hi2; } else { o[1].z = lo; o[1].w = hi2; } }
                unsigned char* qrow = F.XQ8 + (size_t)(m0 + 8 * w + 4 * hb + t4) * DM + 32 * lane;
                *(GAS v4u*)qrow = o[0]; *(GAS v4u*)(qrow + 16) = o[1];
                if (lane == 0) XSL[8 * w + 4 * hb + t4] = xs; } }
          asm volatile("s_waitcnt vmcnt(0)" ::: "memory"); }
        __syncthreads();
        v4u RA[8], RB[8], XA[2], XB[2];
        const bool sb0 = (seg & 1) != 0, sb1 = (seg & 2) != 0, sb2 = (seg & 4) != 0, pb0 = (pg & 1) != 0, pb1 = (pg & 2) != 0, pb2 = (pg & 4) != 0;
        const int krev = 4 * (seg & 1) + (seg & 2) + ((seg >> 2) & 1), jcol = 8 * (pg & 1) + 2 * (pg & 2) + ((pg >> 1) & 2);
        const unsigned seg16 = 16u * seg, seg32 = 32u * seg, seg64 = 64u * seg; const int pg4 = 4 * pg;
#define PX_LOAD8(TB, R, s_, tt_, hf_) do { const unsigned char* b_ = (TB) + (size_t)(s_) * NEXP * 128; const LAS v4u* ip_ = (const LAS v4u*)(IDX2 + (8 * w + (tt_)) * 128 + 8 * (hf_)) + pg4; \
            const v4u i0_ = ip_[0] + seg16, i1_ = ip_[1] + seg16; \
            R[0] = *(const GAS v4u*)(b_ + i0_.x); R[1] = *(const GAS v4u*)(b_ + i0_.y); R[2] = *(const GAS v4u*)(b_ + i0_.z); R[3] = *(const GAS v4u*)(b_ + i0_.w); \
            R[4] = *(const GAS v4u*)(b_ + i1_.x); R[5] = *(const GAS v4u*)(b_ + i1_.y); R[6] = *(const GAS v4u*)(b_ + i1_.z); R[7] = *(const GAS v4u*)(b_ + i1_.w); } while (0)
#define PX_LOADX(X, s_, tt_) do { X[0] = *(const GAS v4u*)(F.XQ8 + (size_t)(m0 + 8 * w + (tt_)) * DM + 128 * (s_) + seg16); } while (0)
        for (int i = tid; i < 64 * 128; i += 512) H2[i] = 0.f;
        __syncthreads();
#define PX_DOT8(R, XC_, own_) do { float d_[8]; \
            _Pragma("unroll") for (int k = 0; k < 8; ++k) { int a_ = __builtin_amdgcn_sdot4((int)R[k].x, (int)XC_[0].x, 0, false); a_ = __builtin_amdgcn_sdot4((int)R[k].y, (int)XC_[0].y, a_, false); \
                a_ = __builtin_amdgcn_sdot4((int)R[k].z, (int)XC_[0].z, a_, false); a_ = __builtin_amdgcn_sdot4((int)R[k].w, (int)XC_[0].w, a_, false); d_[k] = (float)a_; } \
            float e_[4], f_[2]; \
            _Pragma("unroll") for (int k = 0; k < 4; ++k) { const float snd_ = sb0 ? d_[k] : d_[k + 4], kp_ = sb0 ? d_[k + 4] : d_[k]; e_[k] = kp_ + PX_DPP(snd_, 0xB1); } \
            _Pragma("unroll") for (int k = 0; k < 2; ++k) { const float snd_ = sb1 ? e_[k] : e_[k + 2], kp_ = sb1 ? e_[k + 2] : e_[k]; f_[k] = kp_ + PX_DPP(snd_, 0x4E); } \
            { const float snd_ = sb2 ? f_[0] : f_[1], kp_ = sb2 ? f_[1] : f_[0]; own_ = kp_ + __shfl_xor(snd_, 4); } \
            __builtin_amdgcn_sched_barrier(0); } while (0)
#define PX_TOK1(tt, XC, XN_) do { PX_LOAD8(F.U8, RB, s, (tt), 1); __builtin_amdgcn_sched_barrier(0); \
            float own0_, own1_; \
            PX_DOT8(RA, XC, own0_); \
            { const int tn_ = ((tt) + 1) & 7, sn_ = s + (((tt) + 1) >> 3); if (sn_ < 16) { PX_LOAD8(F.U8, RA, sn_, tn_, 0); PX_LOADX(XN_, sn_, tn_); } } \
            __builtin_amdgcn_sched_barrier(0); PX_DOT8(RB, XC, own1_); \
            { LAS float* hp2_ = H2 + (8 * w + (tt)) * 128 + pg * 16 + krev; hp2_[0] += own0_; hp2_[8] += own1_; } } while (0)
        PX_LOAD8(F.U8, RA, 0, 0, 0); PX_LOADX(XA, 0, 0);
#pragma unroll 1
        for (int s = 0; s < 16; ++s) {
#pragma unroll 1
            for (int tp = 0; tp < 8; tp += 2) { PX_TOK1(tp, XA, XB); PX_TOK1(tp + 1, XB, XA); }
        }
#undef PX_TOK1
#undef PX_DOT8
        LDS_WAIT(); asm volatile("" ::: "memory");
        { float su_[16], sv_[16], gt_[16];
#pragma unroll
          for (int q = 0; q < 16; ++q) { const int t = 8 * w + (q >> 1), ii = krev + 8 * (q & 1), p = 8 * ii + pg; const int e = (int)(IDX2[t * 128 + pg * 16 + ii] >> 7);
              su_[q] = F.SC[e] * (RSL[t] * ((LAS float*)(F.lds + L_XS))[t]); sv_[q] = F.SC[NEXP + e]; gt_[q] = F.GATE[(size_t)(m0 + t) * 128 + p]; }
#pragma unroll
          for (int q = 0; q < 16; ++q) { const int t = 8 * w + (q >> 1), ii = krev + 8 * (q & 1); LAS float* hp = H2 + t * 128 + pg * 16 + ii; *hp = gelu_erf(*hp * su_[q]) * (gt_[q] * sv_[q]); } }
        LDS_WAIT(); asm volatile("" ::: "memory");
#define PX_AXPY8(R, tt_, hf_) do { const LAS f32x4* wp_ = (const LAS f32x4*)(H2 + (8 * w + (tt_)) * 128 + 8 * (hf_)) + pg4; const f32x4 w0_ = wp_[0], w1_ = wp_[1]; \
            const float wv_[8] = {w0_.x, w0_.y, w0_.z, w0_.w, w1_.x, w1_.y, w1_.z, w1_.w}; \
            _Pragma("unroll") for (int k = 0; k < 8; ++k) { const f32x2 w2v_ = {wv_[k], wv_[k]}; \
                acc_[0] += PX_CVT(R[k].x, false) * w2v_; acc_[1] += PX_CVT(R[k].x, true) * w2v_; acc_[2] += PX_CVT(R[k].y, false) * w2v_; acc_[3] += PX_CVT(R[k].y, true) * w2v_; \
                acc_[4] += PX_CVT(R[k].z, false) * w2v_; acc_[5] += PX_CVT(R[k].z, true) * w2v_; acc_[6] += PX_CVT(R[k].w, false) * w2v_; acc_[7] += PX_CVT(R[k].w, true) * w2v_; } \
            __builtin_amdgcn_sched_barrier(0); } while (0)
#define PX_TOK2(tt) do { const unsigned hb_ = *(const GAS unsigned*)((const unsigned char*)(HN + (size_t)(m0 + 8 * w + (tt)) * DM + 128 * s) + seg32 + 2u * jcol);     \
            PX_LOAD8(F.V8, RB, s, (tt), 1); __builtin_amdgcn_sched_barrier(0); \
            f32x2 acc_[8]; _Pragma("unroll") for (int k = 0; k < 8; ++k) acc_[k] = (f32x2){0.f, 0.f}; \
            PX_AXPY8(RA, (tt), 0); \
            { const int tn_ = ((tt) + 1) & 7, sn_ = s + (((tt) + 1) >> 3); if (sn_ < 16) PX_LOAD8(F.V8, RA, sn_, tn_, 0); } \
            __builtin_amdgcn_sched_barrier(0); PX_AXPY8(RB, (tt), 1); \
            const int t_ = 8 * w + (tt); \
            float v_[16], e_[8], f_[4], g_[2]; \
            _Pragma("unroll") for (int k = 0; k < 8; ++k) { v_[2 * k] = acc_[k].x; v_[2 * k + 1] = acc_[k].y; } \
            _Pragma("unroll") for (int j = 0; j < 8; ++j) { const float snd_ = pb0 ? v_[j] : v_[j + 8], kp_ = pb0 ? v_[j + 8] : v_[j]; e_[j] = kp_ + PX_DPP(snd_, 0x128); } \
            _Pragma("unroll") for (int j = 0; j < 4; ++j) { const float snd_ = pb1 ? e_[j] : e_[j + 4], kp_ = pb1 ? e_[j + 4] : e_[j]; f_[j] = kp_ + __shfl_xor(snd_, 16); } \
            _Pragma("unroll") for (int j = 0; j < 2; ++j) { const float snd_ = pb2 ? f_[j] : f_[j + 2], kp_ = pb2 ? f_[j + 2] : f_[j]; g_[j] = kp_ + __shfl_xor(snd_, 32); } \
            { unsigned char* ob_ = (unsigned char*)(F.out + (size_t)(m0 + t_) * DM + 128 * s); \
              f32x2 a_ = {bflo(hb_) + g_[0], bfhi(hb_) + g_[1]}; *(GAS f32x2*)(ob_ + seg64 + 4u * jcol) = a_; \
              SSL[t_ * 64 + lane] += a_.x * a_.x + a_.y * a_.y; } \
            __builtin_amdgcn_sched_barrier(0); } while (0)
        PX_LOAD8(F.V8, RA, 0, 0, 0);
#pragma unroll 1
        for (int s = 0; s < 16; ++s) {
#pragma unroll 1
            for (int tp = 0; tp < 8; ++tp) { PX_TOK2(tp); }
        }
#undef PX_TOK2
#undef PX_LOAD8
#undef PX_LOADX
#undef PX_AXPY8
        LDS_WAIT(); asm volatile("s_waitcnt vmcnt(0)" ::: "memory");
        { f32x4 an[8], gfv[8];
#pragma unroll
          for (int k = 0; k < 8; ++k) gfv[k] = *(const GAS f32x4*)(F.lnfg + 256 * k + 4 * lane);
#pragma unroll
          for (int k = 0; k < 8; ++k) an[k] = *((const GAS f32x4*)(F.out + (size_t)(m0 + 8 * w) * DM + 256 * k + 4 * lane));
#pragma unroll 1
          for (int tt = 0; tt < 8; ++tt) { const int t = 8 * w + tt; const float rstd = rsqrtf(wave_sum(SSL[t * 64 + lane]) * (1.f / DM) + EPS);
            float* orow = F.out + (size_t)(m0 + t) * DM; f32x4 a[8];
#pragma unroll
            for (int k = 0; k < 8; ++k) a[k] = an[k];
            if (tt + 1 < 8) {
#pragma unroll
                for (int k = 0; k < 8; ++k) an[k] = *((const GAS f32x4*)(orow + DM + 256 * k + 4 * lane)); }
#pragma unroll
            for (int k = 0; k < 8; ++k) { const f32x4 gg = gfv[k];
                a[k].x *= rstd * gg.x; a[k].y *= rstd * gg.y; a[k].z *= rstd * gg.z; a[k].w *= rstd * gg.w; *(GAS f32x4*)(orow + 256 * k + 4 * lane) = a[k]; } } }
        __syncthreads();
    }
}
}

struct Args { const float* in[15]; float* out; unsigned char* ws; int ph_lo, ph_hi; };
__global__ void __launch_bounds__(NWAVES * 64, 2) fwd(Args args) {
    extern __shared__ __attribute__((aligned(16))) unsigned char lds[];
    Frame F;
    F.lds = (LAS unsigned char*)lds;
    F.MISC = (volatile LAS unsigned*)(F.lds + MISC_OFF);
    F.tid = threadIdx.x; F.lane = F.tid & 63; F.wave = __builtin_amdgcn_readfirstlane(F.tid >> 6);
    F.G = gridDim.x; { const int bx = blockIdx.x; F.vcu = (F.G % 8 == 0) ? (bx % 8) * (F.G / 8) + bx / 8 : bx; }
    unsigned char* ws = args.ws;
    F.ctl = (gu32*)(ws + WS_CTL);
    F.x = args.in[0]; F.ln1g = args.in[1]; F.w_in = args.in[2]; F.rel_bias = args.in[3]; F.wg2 = args.in[4]; F.bgate = args.in[5]; F.gng = args.in[6]; F.w_out = args.in[7];
    F.ln2g = args.in[8]; F.w_q = args.in[9]; F.keys1 = args.in[10]; F.keys2 = args.in[11]; F.pu = args.in[12]; F.pv = args.in[13]; F.lnfg = args.in[14]; F.out = args.out;
    F.WinT = (bf16*)(ws + WS_WIN); F.WoutT = (bf16*)(ws + WS_WOUT); F.WqT = (bf16*)(ws + WS_WQ); F.XN = (bf16*)(ws + WS_XN); F.MIX = (bf16*)(ws + WS_MIX); F.HN = (bf16*)(ws + WS_HN); F.PROJ = (bf16*)(ws + WS_PROJ); F.PQ = (bf16*)(ws + WS_PROJ);
    F.U8 = ws + WS_U; F.V8 = ws + WS_V; F.SC = (float*)(ws + WS_SC); F.GA = (float*)(ws + WS_GA); F.IDX = (int*)(ws + WS_IDX); F.GATE = (float*)(ws + WS_GATE); F.LB = (float*)(ws + WS_LB); F.SSQ = (float*)(ws + WS_SSQ); F.RSTD = (float*)(ws + WS_RSTD); F.RMS1 = (float*)(ws + WS_RMS1); F.XQ8 = ws + WS_XQ8; F.XN8 = ws + WS_XN8; F.WIN8 = ws + WS_WIN8;
    for (int u = F.tid; u < (LDS_BYTES - LDSCTL_OFF) / 4; u += NWAVES * 64) ((LAS unsigned*)(F.lds + LDSCTL_OFF))[u] = 0u;
    __syncthreads();
    XcdBarrier bar; bar.bar = (unsigned*)(F.ctl + CW_BAR); bar.x = 0; bar.st = nullptr;
    if (N_LAUNCHES != PER_PHASE) bar = xcd_barrier_post((unsigned*)(F.ctl + CW_BAR), F.MISC + 8);
#define GRID_BAR(seam) do { if (N_LAUNCHES == PER_PHASE) { if (F.tid == 0) __hip_atomic_store(F.ctl + CW_TMO, 0xBADBA0u | (unsigned)(seam), RLX_AGENT); } else { xcd_barrier(bar); } } while (0)
    const int lo = args.ph_lo, hi = args.ph_hi;
#define IN(k) (lo <= (k) && (k) < hi)
#define BOTH(k) (IN(k) && IN((k) + 1))

    if (IN(0)) { p0_prologue(F); if (BOTH(0)) GRID_BAR(0); }

    if (IN(1)) {
        ga_mfma(F);
        __syncthreads();
        { pg8::Gemm g{(const pg8::bf16_t*)F.XN8, (const pg8::bf16_t*)F.WIN8, T, F8_A1 - F8_A0, DM / 2}; pg8::StaticOrder S; S.init(T, F8_A1 - F8_A0, F.G, (int)blockIdx.x);
          pg8::EpiProj E{F.PROJ, NPROJ, 1.f / WIN8_SCALE, F8_A0 / 256};
          pg8::gemm_phase<pg8::EpiProj, pg8::StaticOrder, true, true, true>(F.lds + RING_OFF, g, S, E); }
        __syncthreads();
        { pg8::Gemm g{F.XN, F.WinT + (size_t)F8_A1 * DM, T, F8_B0 - F8_A1, DM}; pg8::StaticOrder S; S.init(T, F8_B0 - F8_A1, F.G, (int)blockIdx.x);
          pg8::EpiProj E{F.PROJ, NPROJ, 1.f, F8_A1 / 256};
          pg8::gemm_phase<pg8::EpiProj, pg8::StaticOrder, true, true, false>(F.lds + RING_OFF, g, S, E); }
        __syncthreads();
        { pg8::Gemm g{(const pg8::bf16_t*)F.XN8, (const pg8::bf16_t*)(F.WIN8 + (size_t)F8_B0 * DM), T, F8_B1 - F8_B0, DM / 2}; pg8::StaticOrder S; S.init(T, F8_B1 - F8_B0, F.G, (int)blockIdx.x);
          pg8::EpiProj E{F.PROJ, NPROJ, 1.f / WIN8_SCALE, F8_B0 / 256};
          pg8::gemm_phase<pg8::EpiProj, pg8::StaticOrder, true, true, true>(F.lds + RING_OFF, g, S, E); }
        if (BOTH(1)) GRID_BAR(1);
    }

    if (IN(2)) {
        for (int it = F.vcu; it < gla::NITEM; it += F.G) gla::gla_pre_item(F, it >> 7, (it >> 5) & 3, it & 31, it);
        GRID_BAR(8);
        gla::gla_scan(F);
        GRID_BAR(9);
        att::attn_phase(F, F.ctl + CW_ATTQ, gla::NITEM, [&](int it) { gla::gla_post_item(F, it >> 7, (it >> 5) & 3, it & 31, it); });
        if (BOTH(2)) GRID_BAR(2);
    }

    if (IN(3)) {
        pg8::Gemm g{F.MIX, F.WoutT, T, DM, DM}; pg8::StaticOrder S; S.init(T, DM, F.G, (int)blockIdx.x);
        pg8::EpiRes2 E{(const pg8::bf16_t*)F.XN, F.RMS1, F.ln1g, (pg8::bf16_t*)F.HN, F.SSQ, DM, T};
        pg8::gemm_phase<pg8::EpiRes2, pg8::StaticOrder, true, true>(F.lds + RING_OFF, g, S, E);
        if (IN(5)) GRID_BAR(3);
    }


    if (IN(5)) {
        pg8::Gemm g{F.HN, F.WqT, T, DM, DM}; pg8::StaticOrder S; S.init(T, DM, F.G, (int)blockIdx.x);
        pg8::EpiBf16<0> E{F.PQ, DM, nullptr, 0, 0, 1.f};
        pg8::gemm_phase<pg8::EpiBf16<0>, pg8::StaticOrder, true, true>(F.lds + RING_OFF, g, S, E);
        if (BOTH(5)) GRID_BAR(5);
    }

    if (IN(6)) { pks::peer_score(F); if (BOTH(6)) { asm volatile("s_waitcnt vmcnt(0)" ::: "memory"); __syncthreads(); } }

    if (IN(7)) { pex::peer_experts(F); }
#undef IN
#undef BOTH
}

extern "C" void kernel_launch(void* const* d_in, const int* in_sizes, int n_in, void* d_out, int out_size, void* d_ws, size_t ws_size, hipStream_t stream) {
    static int grid = 0;
    if (grid == 0) {
        if (n_in != 15 || in_sizes[0] != T * DM || out_size != T * DM || ws_size < WS_END) { fprintf(stderr, "kernel_launch: unexpected shapes (n_in %d in0 %d out %d ws %zu)\n", n_in, n_in > 0 ? in_sizes[0] : -1, out_size, ws_size); grid = -1; return; }
        int dev = 0, cus = 0, per_cu = 0;
        if (hipGetDevice(&dev) != hipSuccess || hipDeviceGetAttribute(&cus, hipDeviceAttributeMultiprocessorCount, dev) != hipSuccess) { grid = -1; return; }
        if (hipFuncSetAttribute((const void*)fwd, hipFuncAttributeMaxDynamicSharedMemorySize, LDS_BYTES) != hipSuccess) { fprintf(stderr, "kernel_launch: hipFuncSetAttribute failed\n"); grid = -1; return; }
        if (hipOccupancyMaxActiveBlocksPerMultiprocessor(&per_cu, (const void*)fwd, NWAVES * 64, LDS_BYTES) != hipSuccess || per_cu < 1) fprintf(stderr, "kernel_launch: occupancy query reports %d\n", per_cu);
        (void)hipGetLastError();
        grid = cus;
    }
    if (grid < 0) return;
    if (hipMemsetAsync((char*)d_ws + WS_CTL, 0, CTL_ZERO_BYTES, stream) != hipSuccess) return;
    Args a{};
    for (int i = 0; i < 15; ++i) a.in[i] = (const float*)d_in[i];
    a.out = (float*)d_out; a.ws = (unsigned char*)d_ws;
    for (int li = 0; li < N_LAUNCHES; ++li) {
        a.ph_lo = (N_LAUNCHES == PER_PHASE) ? li : 0; a.ph_hi = (N_LAUNCHES == PER_PHASE) ? li + 1 : PER_PHASE;
        hipLaunchKernelGGL(fwd, dim3(grid), dim3(NWAVES * 64), LDS_BYTES, stream, a);
        const hipError_t le = hipPeekAtLastError();
        if (le != hipSuccess) { fprintf(stderr, "kernel_launch: launch %d failed: %s\n", li, hipGetErrorName(le)); break; }
    }
}
```

```cpp
#include <hip/hip_runtime.h>
#include <cstdio>
#include <cstdint>
#include <cmath>
namespace pg8 {
#define PG8_LAS __attribute__((address_space(3)))
typedef unsigned short bf16_t;
typedef short bf16x8 __attribute__((ext_vector_type(8)));
typedef float f32x4 __attribute__((ext_vector_type(4)));
typedef unsigned u32x4 __attribute__((ext_vector_type(4)));
constexpr int BM = 256, BK = 64, HALF = 128, HTB = HALF * BK * 2  , STAGE_BYTES = 8 * HTB, NXCD = 8, WGM = 8;

__host__ __device__ __forceinline__ int lds_byte(int r, int c) { const int st = (r >> 4) * 2 + (c >> 5), rr = r & 15, cc = c & 31, ob = rr * 64 + cc * 2; return st * 1024 + (ob ^ (((ob >> 9) & 1) << 5)); }
__host__ __device__ __forceinline__ void stage_rc(int b, int& R, int& C) { const int st = b / 1024, sb = b % 1024, swz = sb ^ (((sb >> 9) & 1) << 5); R = (st >> 1) * 16 + swz / 64; C = (st & 1) * 32 + (swz % 64) / 2; }
__host__ __device__ __forceinline__ int perm32(int rho) { const int n = rho >> 4, i = rho & 15; return 8 * (i >> 2) + 4 * n + (i & 3); }

struct Unit { int pm, pn; };
struct Gemm { const bf16_t* A; const bf16_t* Bt; int M, N, K; };

struct StaticOrder {
    int nM, nN, nwg, G, c;
    __host__ __device__ void init(int M, int N, int G_, int c_) { nM = M / BM; nN = N / BM; nwg = nM * nN; G = G_; c = c_; }
    __host__ __device__ bool next(int i, Unit& u) const {
        const long L = (long)i * G + c; if (L >= nwg) return false;
        int wgid = (int)L; { const int q = nwg / NXCD, r = nwg % NXCD, xcd = wgid % NXCD, off = wgid / NXCD; wgid = (xcd < r ? xcd * (q + 1) : r * (q + 1) + (xcd - r) * q) + off; }
        const int nig = WGM * nN, gid = wgid / nig, fm = gid * WGM, gsz = (nM - fm) < WGM ? (nM - fm) : WGM;
        u.pm = fm + ((wgid % nig) % gsz); u.pn = (wgid % nig) / gsz; return true;
    }
    __device__ __forceinline__ void a_ready(const Unit&) const {}
    __device__ __forceinline__ void done(const Unit&) const {}
};

__device__ __forceinline__ unsigned cvt_pk_bf16(float lo, float hi) { unsigned r; asm volatile("v_cvt_pk_bf16_f32 %0, %1, %2" : "=v"(r) : "v"(lo), "v"(hi)); return r; }
typedef float f32x2 __attribute__((ext_vector_type(2)));
__device__ __forceinline__ f32x2 gelu_pk(f32x2 v) {
    const f32x2 av = __builtin_elementwise_abs(v), d = av * 0.2316418882f + 1.0f;
    f32x2 t; t.x = __builtin_amdgcn_rcpf(d.x); t.y = __builtin_amdgcn_rcpf(d.y);
    f32x2 q = t * 0.5307027145f + (-0.7265760135f); q = q * t + 0.7107068705f; q = q * t + (-0.142248368f); q = q * t + 0.127414796f; q = q * t;
    const f32x2 s = (v * v) * (-0.72134752044f);
    f32x2 e; e.x = __builtin_amdgcn_exp2f(s.x); e.y = __builtin_amdgcn_exp2f(s.y);
    const f32x2 m = v * (q * e), r = v - m;
    f32x2 o; o.x = v.x < 0.f ? m.x : r.x; o.y = v.y < 0.f ? m.y : r.y; return o;
}

template <int ACT  > struct EpiBf16 {
    static constexpr bool PERM = true, AFTER_DRAIN = false; static_assert(ACT == 0 || ACT == 1, "EpiBf16: ACT is 0 (none) or 1 (gelu_pk)");
    bf16_t* O; int ldc; const float* bias; int split_cols; size_t split_stride; float scale0;
    __device__ __forceinline__ void operator()(const f32x4 (&acc)[2][2][4][2], const Unit& u, int wr, int wc, int fr, int fq) const {
        const int row0 = u.pm * BM + wr * 64 + fr; int colt = u.pn * BM; bf16_t* base = O;
        float sc = 1.f; if (split_cols) { const int t = colt / split_cols; base += (size_t)t * split_stride; colt -= t * split_cols; if (t == 0) sc = scale0; }
        const int col0 = colt + wc * 32 + 8 * fq, bcol0 = u.pn * BM + wc * 32 + 8 * fq;
        f32x4 bv[2][2];
#pragma unroll
        for (int bj = 0; bj < 2; ++bj)
#pragma unroll
            for (int n = 0; n < 2; ++n) bv[bj][n] = bias ? *(const f32x4*)(bias + bcol0 + bj * HALF + 4 * n) : (f32x4){0.f, 0.f, 0.f, 0.f};
#pragma unroll
        for (int ai = 0; ai < 2; ++ai)
#pragma unroll
            for (int m = 0; m < 4; ++m) { bf16_t* rowp = base + (size_t)(row0 + ai * HALF + m * 16) * ldc + col0;
#pragma unroll
                for (int bj = 0; bj < 2; ++bj) { f32x4 v0 = acc[ai][bj][m][0] + bv[bj][0], v1 = acc[ai][bj][m][1] + bv[bj][1];
                    if (ACT == 1) { f32x2 a = gelu_pk((f32x2){v0[0], v0[1]}), b = gelu_pk((f32x2){v0[2], v0[3]}), c = gelu_pk((f32x2){v1[0], v1[1]}), d = gelu_pk((f32x2){v1[2], v1[3]});
                        v0 = (f32x4){a.x, a.y, b.x, b.y}; v1 = (f32x4){c.x, c.y, d.x, d.y}; }
                    v0 = v0 * sc; v1 = v1 * sc; u32x4 w; w.x = cvt_pk_bf16(v0[0], v0[1]); w.y = cvt_pk_bf16(v0[2], v0[3]); w.z = cvt_pk_bf16(v1[0], v1[1]); w.w = cvt_pk_bf16(v1[2], v1[3]);
                    *(u32x4*)(rowp + bj * HALF) = w; } }
    }
};

template <class Epi, class Sched, bool ALIGN_EPI = false, bool SP2 = false, bool FP8 = false>
__device__ __forceinline__ void gemm_phase(PG8_LAS unsigned char* lds, const Gemm g, const Sched& S, const Epi& E) {
    const int tid = threadIdx.x, wid = __builtin_amdgcn_readfirstlane(tid >> 6), lane = tid & 63, wr = wid >> 2, wc = wid & 3, fr = lane & 15, fq = lane >> 4;
    const int K = g.K, nt = K / BK;
    unsigned voffA[2], voffB[2];
#pragma unroll
    for (int i = 0; i < 2; ++i) { int R, C; stage_rc(tid * 16 + i * 8192, R, C); const int Rb = Epi::PERM ? ((R & ~31) + perm32(R & 31)) : R;
        voffA[i] = (unsigned)(R * K + C) * 2u; voffB[i] = (unsigned)(Rb * K + C) * 2u; }
    const size_t kstep = (size_t)(BK * 2);
    const size_t hstep = (size_t)HALF * K * 2;
    const size_t tstep = 2 * hstep;
    const unsigned ldsw = (unsigned)wid * 1024u;
    const int aoff = lds_byte(wr * 64 + fr, fq * 8), boff = lds_byte(wc * 32 + fr, fq * 8);
#define PG8_SA(b, h) (((b) * 2 + (h)) * HTB)
#define PG8_SB(b, h) ((4 + (b) * 2 + (h)) * HTB)
#define PG8_STAGE(bufoff, gbase, voff) do { _Pragma("unroll") for (int _i = 0; _i < 2; ++_i) \
        __builtin_amdgcn_global_load_lds((const unsigned*)((const char*)(gbase) + (voff)[_i]), (PG8_LAS unsigned*)(lds + (bufoff) + ldsw + _i * 8192), 16, 0, 0); } while (0)
#define PG8_LDA(dst, b, h) do { if constexpr (FP8) { _Pragma("unroll") for (int m = 0; m < 4; ++m) { const pg8_v4i lo_ = *(const PG8_LAS pg8_v4i*)(lds + PG8_SA(b, h) + aoff + m * 2048), hi_ = *(const PG8_LAS pg8_v4i*)(lds + PG8_SA(b, h) + aoff + m * 2048 + 1024); \
            dst##8[m] = __builtin_shufflevector(lo_, hi_, 0, 1, 2, 3, 4, 5, 6, 7); } } \
        else { _Pragma("unroll") for (int m = 0; m < 4; ++m) _Pragma("unroll") for (int k = 0; k < 2; ++k) dst[m][k] = *(const PG8_LAS bf16x8*)(lds + PG8_SA(b, h) + aoff + m * 2048 + k * 1024); } } while (0)
#define PG8_LDB(dst, b, h) do { if constexpr (FP8) { _Pragma("unroll") for (int n = 0; n < 2; ++n) { const pg8_v4i lo_ = *(const PG8_LAS pg8_v4i*)(lds + PG8_SB(b, h) + boff + n * 2048), hi_ = *(const PG8_LAS pg8_v4i*)(lds + PG8_SB(b, h) + boff + n * 2048 + 1024); \
            dst##8[n] = __builtin_shufflevector(lo_, hi_, 0, 1, 2, 3, 4, 5, 6, 7); } } \
        else { _Pragma("unroll") for (int n = 0; n < 2; ++n) _Pragma("unroll") for (int k = 0; k < 2; ++k) dst[n][k] = *(const PG8_LAS bf16x8*)(lds + PG8_SB(b, h) + boff + n * 2048 + k * 1024); } } while (0)
#define PG8_MMA(ai, bj, At, Bt) do { __builtin_amdgcn_s_setprio(1); _Pragma("unroll") for (int m = 0; m < 4; ++m) _Pragma("unroll") for (int n = 0; n < 2; ++n) { \
        if constexpr (FP8) asm volatile("v_mfma_f32_16x16x128_f8f6f4 %0, %1, %2, %0" : "+v"(acc[ai][bj][m][n]) : "v"(Bt##8[n]), "v"(At##8[m]));     \
        else { _Pragma("unroll") for (int k = 0; k < 2; ++k) acc[ai][bj][m][n] = __builtin_amdgcn_mfma_f32_16x16x32_bf16(Bt[n][k], At[m][k], acc[ai][bj][m][n], 0, 0, 0); } } \
        __builtin_amdgcn_s_setprio(0); } while (0)
#define PG8_WAIT_V(n) asm volatile("s_waitcnt vmcnt(" #n ")" ::: "memory")
#define PG8_WAIT_L(n) asm volatile("s_waitcnt lgkmcnt(" #n ")" ::: "memory")
#define PG8_BAR __builtin_amdgcn_s_barrier()
#define PG8_SCHED __builtin_amdgcn_sched_barrier(0)
    Unit cur, nxt; int ui = 0;
    if (!S.next(0, cur)) return;
    f32x4 acc[2][2][4][2];
#pragma unroll
    for (int a = 0; a < 2; ++a)
#pragma unroll
        for (int b = 0; b < 2; ++b)
#pragma unroll
            for (int m = 0; m < 4; ++m)
#pragma unroll
                for (int n = 0; n < 2; ++n) acc[a][b][m][n] = (f32x4){0.f, 0.f, 0.f, 0.f};
    typedef int pg8_v4i __attribute__((ext_vector_type(4))); typedef int pg8_v8i __attribute__((ext_vector_type(8)));
    bf16x8 At[4][2], B0[2][2], B1[2][2]; pg8_v8i At8[4], B08[2], B18[2];
    const char* cA = (const char*)g.A + (size_t)cur.pm * tstep; const char* cB = (const char*)g.Bt + (size_t)cur.pn * tstep;
    S.a_ready(cur);
    if constexpr (SP2) {
        PG8_STAGE(PG8_SB(0, 0), cB, voffB); PG8_STAGE(PG8_SB(0, 1), cB + hstep, voffB); PG8_STAGE(PG8_SA(0, 0), cA, voffA); PG8_STAGE(PG8_SA(0, 1), cA + hstep, voffA);
        if (wr == 1) PG8_BAR;
        PG8_WAIT_V(2); PG8_BAR;
        PG8_STAGE(PG8_SB(1, 0), cB + kstep, voffB); PG8_STAGE(PG8_SA(1, 0), cA + kstep, voffA); PG8_STAGE(PG8_SB(1, 1), cB + hstep + kstep, voffB);
        PG8_WAIT_V(6); PG8_BAR;
    } else {
        PG8_STAGE(PG8_SB(0, 0), cB, voffB); PG8_STAGE(PG8_SA(0, 0), cA, voffA); PG8_STAGE(PG8_SB(0, 1), cB + hstep, voffB); PG8_STAGE(PG8_SA(0, 1), cA + hstep, voffA);
        if (wr == 1) PG8_BAR;
        PG8_WAIT_V(4); PG8_BAR;
        PG8_STAGE(PG8_SB(1, 0), cB + kstep, voffB); PG8_STAGE(PG8_SA(1, 0), cA + kstep, voffA); PG8_STAGE(PG8_SB(1, 1), cB + hstep + kstep, voffB);
        PG8_WAIT_V(6); PG8_BAR;
    }
    for (;;) {
        const bool has_next = S.next(ui + 1, nxt);
        const char* nA = has_next ? (const char*)g.A + (size_t)nxt.pm * tstep : cA; const char* nB = has_next ? (const char*)g.Bt + (size_t)nxt.pn * tstep : cB;
        for (int t = 0; t < nt; t += 2) {
            const bool last = (t == nt - 2);
            const char* a1 = cA + (size_t)(t + 1) * kstep;
            const char* a2 = last ? nA : cA + (size_t)(t + 2) * kstep; const char* b2 = last ? nB : cB + (size_t)(t + 2) * kstep;
            const char* a3 = a2 + kstep; const char* b3 = b2 + kstep;
            if (last && has_next) S.a_ready(nxt);
            if constexpr (SP2) {
            PG8_LDB(B0, 0, 0); PG8_LDB(B1, 0, 1); PG8_SCHED; PG8_LDA(At, 0, 0); PG8_STAGE(PG8_SA(1, 1), a1 + hstep, voffA);
            PG8_WAIT_V(8); PG8_WAIT_L(0); PG8_BAR; PG8_MMA(0, 0, At, B0); PG8_MMA(0, 1, At, B1); PG8_BAR; PG8_SCHED;
            PG8_LDA(At, 0, 1); PG8_STAGE(PG8_SB(0, 0), b2, voffB); PG8_STAGE(PG8_SB(0, 1), b2 + hstep, voffB); PG8_STAGE(PG8_SA(0, 0), a2, voffA);
            PG8_WAIT_V(8); PG8_WAIT_L(0); PG8_BAR; PG8_MMA(1, 0, At, B0); PG8_MMA(1, 1, At, B1); PG8_BAR; PG8_SCHED;
            PG8_LDB(B0, 1, 0); PG8_LDB(B1, 1, 1); PG8_SCHED; PG8_LDA(At, 1, 0); PG8_STAGE(PG8_SA(0, 1), a2 + hstep, voffA);
            PG8_WAIT_V(8); PG8_WAIT_L(0); PG8_BAR; PG8_MMA(0, 0, At, B0); PG8_MMA(0, 1, At, B1); PG8_BAR; PG8_SCHED;
            PG8_LDA(At, 1, 1); PG8_STAGE(PG8_SB(1, 0), b3, voffB); PG8_STAGE(PG8_SB(1, 1), b3 + hstep, voffB); PG8_STAGE(PG8_SA(1, 0), a3, voffA);
            PG8_WAIT_V(8); PG8_WAIT_L(0); PG8_BAR; PG8_MMA(1, 0, At, B0); PG8_MMA(1, 1, At, B1); PG8_BAR; PG8_SCHED;
            } else {
            PG8_LDB(B0, 0, 0); PG8_SCHED; PG8_LDA(At, 0, 0); PG8_STAGE(PG8_SA(1, 1), a1 + hstep, voffA);
            PG8_WAIT_L(8); PG8_BAR; PG8_WAIT_L(0); PG8_MMA(0, 0, At, B0); PG8_BAR; PG8_SCHED;
            PG8_LDB(B1, 0, 1); PG8_STAGE(PG8_SB(0, 0), b2, voffB);
            PG8_BAR; PG8_WAIT_L(0); PG8_MMA(0, 1, At, B1); PG8_BAR;
            PG8_LDA(At, 0, 1); PG8_STAGE(PG8_SA(0, 0), a2, voffA);
            PG8_BAR; PG8_WAIT_L(0); PG8_MMA(1, 0, At, B0); PG8_BAR; PG8_SCHED;
            PG8_STAGE(PG8_SB(0, 1), b2 + hstep, voffB);
            PG8_WAIT_V(6); PG8_BAR; PG8_MMA(1, 1, At, B1); PG8_BAR;
            PG8_LDB(B0, 1, 0); PG8_SCHED; PG8_LDA(At, 1, 0); PG8_STAGE(PG8_SA(0, 1), a2 + hstep, voffA);
            PG8_WAIT_L(8); PG8_BAR; PG8_WAIT_L(0); PG8_MMA(0, 0, At, B0); PG8_BAR; PG8_SCHED;
            PG8_LDB(B1, 1, 1); PG8_STAGE(PG8_SB(1, 0), b3, voffB);
            PG8_BAR; PG8_WAIT_L(0); PG8_MMA(0, 1, At, B1); PG8_BAR;
            PG8_LDA(At, 1, 1); PG8_STAGE(PG8_SA(1, 0), a3, voffA);
            PG8_BAR; PG8_WAIT_L(0); PG8_MMA(1, 0, At, B0); PG8_BAR; PG8_SCHED;
            PG8_STAGE(PG8_SB(1, 1), b3 + hstep, voffB);
            PG8_WAIT_V(6); PG8_BAR; PG8_MMA(1, 1, At, B1); PG8_BAR;
            }
        }
        if constexpr (ALIGN_EPI) { if (wr == 0) PG8_BAR; }
        if constexpr (FP8) asm volatile("s_nop 15\n\ts_nop 15\n\ts_nop 15" ::: "memory");
        if constexpr (!Epi::AFTER_DRAIN) {
            if constexpr (FP8) { const int l2_ = (int)__builtin_amdgcn_mbcnt_hi(~0u, __builtin_amdgcn_mbcnt_lo(~0u, 0u));
                E(acc, cur, wr, wc, l2_ & 15, l2_ >> 4); }
            else E(acc, cur, wr, wc, fr, fq);
            S.done(cur); }
        if (!has_next) break;
#pragma unroll
        for (int a = 0; a < 2; ++a)
#pragma unroll
            for (int b = 0; b < 2; ++b)
#pragma unroll
                for (int m = 0; m < 4; ++m)
#pragma unroll
                    for (int n = 0; n < 2; ++n) acc[a][b][m][n] = (f32x4){0.f, 0.f, 0.f, 0.f};
        cur = nxt; cA = nA; cB = nB; ++ui;
        if constexpr (ALIGN_EPI) { if (wr == 1) PG8_BAR; }
    }
    PG8_WAIT_V(0);
    if constexpr (!ALIGN_EPI) { if (wr == 0) PG8_BAR; }
    PG8_BAR;
    if constexpr (Epi::AFTER_DRAIN) { E.fused(acc, cur, wr, wc, fr, fq, lds, wid, lane); S.done(cur); }
#undef PG8_SA
#undef PG8_SB
#undef PG8_STAGE
#undef PG8_LDA
#undef PG8_LDB
#undef PG8_MMA
#undef PG8_WAIT_V
#undef PG8_WAIT_L
#undef PG8_BAR
#undef PG8_SCHED
}
}

constexpr int NWAVES = 8;
#ifndef MK_N_LAUNCHES
#define MK_N_LAUNCHES 1
#endif
constexpr int N_LAUNCHES = MK_N_LAUNCHES;
constexpr int PER_PHASE = 8;

constexpr int BATCH = 8, SEQ = 2048, DM = 2048, T = BATCH * SEQ;
constexpr int NH = 16, HD = 64;
constexpr int NGH = 4, GDK = 128, GDV = 256, GRANK = 16;
constexpr int DIN = 6160, NPROJ = 6144;
constexpr int C_AQ = 0, C_AK = 1024, C_AV = 2048, C_GQ = 3072, C_GK = 3584, C_GV = 4096, C_GR = 5120;
constexpr int PEH = 8, PEK = 128, PETOP = 16, NEXP = 16384;
constexpr float EPS = 1e-6f;
constexpr float LOG2E = 1.4426950408889634f;
constexpr float QSCALE = 0.125f * LOG2E;
constexpr float GQSCALE = 0.08838834764831845f;

constexpr size_t MiB = 1u << 20;
constexpr size_t WS_CTL = 0, CTL_ZERO_BYTES = 32 * 1024;
constexpr size_t WS_WIN = 1 * MiB;
constexpr size_t WS_WOUT = 26 * MiB;
constexpr size_t WS_WQ = 34 * MiB;
constexpr size_t WS_XN = 42 * MiB;
constexpr size_t WS_PROJ = 106 * MiB;
constexpr size_t WS_U = 298 * MiB;
constexpr size_t WS_V = 330 * MiB;
constexpr size_t WS_SC = 362 * MiB;
constexpr size_t WS_MIX = 363 * MiB;
constexpr size_t WS_GA = 427 * MiB;
constexpr size_t WS_IDX = 428 * MiB;
constexpr size_t WS_GATE = 436 * MiB;
constexpr size_t WS_LB = 444 * MiB;
constexpr size_t WS_HN = 445 * MiB;
constexpr size_t WS_SSQ = 509 * MiB;
constexpr size_t WS_RSTD = 362 * MiB + 512 * 1024;
constexpr size_t WS_XQ8 = WS_PROJ + 64 * MiB;
constexpr size_t WS_XN8 = WS_HN;
constexpr size_t WS_WIN8 = WS_HN + 32 * MiB;
constexpr float WIN8_SCALE = 128.f;
constexpr size_t WS_MIX8 = WS_MIX;
constexpr size_t WS_WOUT8 = WS_MIX + 32 * MiB;
constexpr float MIX8_SCALE = 16.f;
constexpr int F8_A0 = 0, F8_A1 = 3072, F8_B0 = 4096, F8_B1 = 6144;
__host__ __device__ constexpr bool is_f8_col(int n) { return (n >= F8_A0 && n < F8_A1) || (n >= F8_B0 && n < F8_B1); }
constexpr size_t WS_RMS1 = 362 * MiB + 640 * 1024;
constexpr size_t WS_END = 511 * MiB;
constexpr int CW_TMO = 0, CW_CODE = 1, CW_ATTQ = 64, CW_BAR = 4096;

constexpr int RING_OFF = 0, RING_BYTES = 131072;
constexpr int LDS_BYTES = 147456;
constexpr int LDSCTL_OFF = LDS_BYTES - 512, MISC_OFF = LDSCTL_OFF + 320;

#define GAS __attribute__((address_space(1)))
#define LAS __attribute__((address_space(3)))
typedef unsigned short bf16;
typedef unsigned v4u __attribute__((ext_vector_type(4)));
typedef unsigned v2u __attribute__((ext_vector_type(2)));
typedef float f32x4 __attribute__((ext_vector_type(4)));
typedef short bf16x8 __attribute__((ext_vector_type(8)));
typedef GAS unsigned gu32;
#define RLX_AGENT __ATOMIC_RELAXED, __HIP_MEMORY_SCOPE_AGENT
#define LDS_WAIT() asm volatile("s_waitcnt lgkmcnt(0)" ::: "memory")
#define VM_WAIT() asm volatile("s_waitcnt vmcnt(0)" ::: "memory")
__device__ __forceinline__ unsigned f2bf(float f) { unsigned u = __builtin_bit_cast(unsigned, f); return (u + 0x7fffu + ((u >> 16) & 1u)) >> 16; }
__device__ __forceinline__ unsigned pk2(float lo, float hi) { return f2bf(lo) | (f2bf(hi) << 16); }
__device__ __forceinline__ float bf2f(unsigned short b) { return __builtin_bit_cast(float, (unsigned)b << 16); }
__device__ __forceinline__ float bflo(unsigned w) { return __builtin_bit_cast(float, w << 16); }
__device__ __forceinline__ float bfhi(unsigned w) { return __builtin_bit_cast(float, w & 0xffff0000u); }
__device__ __forceinline__ unsigned bf4_to_f8(unsigned lo, unsigned hi) {
    int w = 0; w = __builtin_amdgcn_cvt_pk_fp8_f32(bflo(lo) * MIX8_SCALE, bfhi(lo) * MIX8_SCALE, w, false); w = __builtin_amdgcn_cvt_pk_fp8_f32(bflo(hi) * MIX8_SCALE, bfhi(hi) * MIX8_SCALE, w, true); return (unsigned)w; }

#define XB_TMO      128
#define XB_XCNT(j)  (256  + 64 * (j))
#define XB_XSUB(j)  (1280 + 64 * (j))
#define XB_XGEN(j)  (2304 + 64 * (j))
#define XB_TOP      3328
#define XB_TOPGEN   3392
#define XCD_BAR_WORDS 3456
#define XB_SPIN_CAP (1u << 22)

__device__ __forceinline__ unsigned xb_ld(unsigned* p)              { return __hip_atomic_load(p, __ATOMIC_RELAXED, __HIP_MEMORY_SCOPE_AGENT); }
__device__ __forceinline__ unsigned xb_add(unsigned* p, unsigned v) { return __hip_atomic_fetch_add(p, v, __ATOMIC_RELAXED, __HIP_MEMORY_SCOPE_AGENT); }
__device__ __forceinline__ unsigned xb_xcc_id() { return (unsigned)__builtin_amdgcn_s_getreg((3 << 11) | 20) & 0xFu; }
#define XB_SPIN(cond, bar) do { unsigned _sp = 0; while (cond) { __builtin_amdgcn_s_sleep(1); \
    if ((++_sp & 255u) == 0u) { if (xb_ld(&(bar)[XB_TMO])) break; if (_sp > XB_SPIN_CAP) { atomicAdd(&(bar)[XB_TMO], 1u); break; } } } } while (0)

struct XcdBarrier { unsigned* bar; unsigned x; volatile LAS unsigned* st; };

__device__ __forceinline__ XcdBarrier xcd_barrier_post(unsigned* bar, volatile LAS unsigned* st) {
    XcdBarrier b; b.bar = bar; b.x = xb_xcc_id(); b.st = st;
    if (threadIdx.x == 0) (void)xb_add(&bar[XB_XCNT(b.x)], 1u);
    return b;
}
__device__ __forceinline__ void xcd_barrier_complete(unsigned* bar, unsigned x, unsigned& nloc, unsigned& nx) {
    const unsigned G = gridDim.x * gridDim.y * gridDim.z;
    unsigned sum, cnt, mine, sp = 0u;
    for (;;) {
        sum = 0u; cnt = 0u; mine = 0u;
#pragma unroll
        for (unsigned j = 0; j < 16; ++j) { const unsigned c = xb_ld(&bar[XB_XCNT(j)]); sum += c; cnt += (c > 0u) ? 1u : 0u; mine = (j == x) ? c : mine; }
        if (sum == G) break;
        __builtin_amdgcn_s_sleep(1);
        if ((++sp & 255u) == 0u) { if (xb_ld(&bar[XB_TMO])) break; if (sp > XB_SPIN_CAP) { atomicAdd(&bar[XB_TMO], 1u); break; } }
    }
    nloc = mine > 0u ? mine : 1u; nx = cnt > 0u ? cnt : 1u;
}
__device__ __forceinline__ void xcd_barrier(const XcdBarrier& b) {
    asm volatile("s_waitcnt vmcnt(0)" ::: "memory");
    __syncthreads();
    if (threadIdx.x == 0) {
        unsigned* bar = b.bar;
        __builtin_amdgcn_s_waitcnt(0);
        unsigned nloc = b.st[0], nx = b.st[1];
        if (nloc == 0u) { xcd_barrier_complete(bar, b.x, nloc, nx); b.st[0] = nloc; b.st[1] = nx; }
        const unsigned old = xb_add(&bar[XB_XSUB(b.x)], 1u);
        const unsigned gen = old / nloc;
        if (old + 1u == (gen + 1u) * nloc) {
            __builtin_amdgcn_fence(__ATOMIC_RELEASE, "agent");
            asm volatile("s_waitcnt vmcnt(0)" ::: "memory");
            const unsigned og = xb_add(&bar[XB_TOP], 1u);
            const unsigned tg = og / nx;
            if (og + 1u == (tg + 1u) * nx) xb_add(&bar[XB_TOPGEN], 1u);
            else XB_SPIN(xb_ld(&bar[XB_TOPGEN]) == tg, bar);
            __builtin_amdgcn_fence(__ATOMIC_ACQUIRE, "agent"); asm volatile("buffer_inv sc0 sc1" ::: "memory");
            xb_add(&bar[XB_XGEN(b.x)], 1u);
            asm volatile("s_waitcnt vmcnt(0)" ::: "memory");
        } else {
            XB_SPIN(xb_ld(&bar[XB_XGEN(b.x)]) == gen, bar);
            __builtin_amdgcn_fence(__ATOMIC_ACQUIRE, "agent"); asm volatile("buffer_inv sc0 sc1" ::: "memory");
            asm volatile("s_waitcnt vmcnt(0)" ::: "memory");
        }
    }
    __syncthreads();
}

namespace pg8 {
struct EpiProj {
    static constexpr bool PERM = true, AFTER_DRAIN = false;
    bf16_t* O; int ldc; float osc; int pn0;
    __device__ __forceinline__ void operator()(const f32x4 (&acc)[2][2][4][2], const Unit& u, int wr, int wc, int fr, int fq) const {
        const int row0 = u.pm * BM + wr * 64 + fr; const int col0 = (u.pn + pn0) * BM + wc * 32 + 8 * fq;
        const float sc = ((u.pn + pn0 < 4) ? QSCALE : 1.f) * osc;
#pragma unroll
        for (int ai = 0; ai < 2; ++ai)
#pragma unroll
            for (int m = 0; m < 4; ++m) { bf16_t* rowp = O + (size_t)(row0 + ai * HALF + m * 16) * ldc + col0;
#pragma unroll
                for (int bj = 0; bj < 2; ++bj) { f32x4 v0 = acc[ai][bj][m][0] * sc, v1 = acc[ai][bj][m][1] * sc;
                    u32x4 w; w.x = cvt_pk_bf16(v0[0], v0[1]); w.y = cvt_pk_bf16(v0[2], v0[3]); w.z = cvt_pk_bf16(v1[0], v1[1]); w.w = cvt_pk_bf16(v1[2], v1[3]);
                    *(u32x4*)(rowp + bj * HALF) = w; } }
    }
};
struct EpiRes {
    static constexpr bool PERM = false, AFTER_DRAIN = false;
    const float* base; float* C; int ldc;
    __device__ __forceinline__ void operator()(const f32x4 (&acc)[2][2][4][2], const Unit& u, int wr, int wc, int fr, int fq) const {
        const int row0 = u.pm * BM + wr * 64 + fr, col0 = u.pn * BM + wc * 32 + 4 * fq;
#pragma unroll
        for (int ai = 0; ai < 2; ++ai)
#pragma unroll
            for (int m = 0; m < 4; ++m) { const size_t off = (size_t)(row0 + ai * HALF + m * 16) * ldc + col0;
#pragma unroll
                for (int bj = 0; bj < 2; ++bj)
#pragma unroll
                    for (int n = 0; n < 2; ++n) *(f32x4*)(C + off + bj * HALF + n * 16) = acc[ai][bj][m][n] + *(const f32x4*)(base + off + bj * HALF + n * 16); }
    }
};
struct EpiRes2 {
    static constexpr bool PERM = true, AFTER_DRAIN = false;
    const bf16_t* XNb; const float* RMS1; const float* G1; bf16_t* CB; float* SSQ; int ldc; int M; float osc;
    __device__ __forceinline__ void operator()(const f32x4 (&acc)[2][2][4][2], const Unit& u, int wr, int wc, int fr, int fq) const {
        const int row0 = u.pm * BM + wr * 64 + fr, col0 = u.pn * BM + wc * 32 + 8 * fq;
        float* sq = SSQ + (size_t)(u.pn * 4 + wc) * M;
        f32x4 ig[2][2];
#pragma unroll
        for (int bj = 0; bj < 2; ++bj)
#pragma unroll
            for (int n = 0; n < 2; ++n) { const f32x4 g = *(const f32x4*)(G1 + col0 + bj * HALF + 4 * n); ig[bj][n] = (f32x4){1.f / g[0], 1.f / g[1], 1.f / g[2], 1.f / g[3]}; }
#pragma unroll
        for (int ai = 0; ai < 2; ++ai) {
            u32x4 xb[4][2]; float rm[4];
#pragma unroll
            for (int m = 0; m < 4; ++m)
#pragma unroll
                for (int bj = 0; bj < 2; ++bj) xb[m][bj] = *(const u32x4*)(XNb + (size_t)(row0 + ai * HALF + m * 16) * ldc + col0 + bj * HALF);
#pragma unroll
            for (int m = 0; m < 4; ++m) rm[m] = RMS1[row0 + ai * HALF + m * 16];
#pragma unroll
            for (int m = 0; m < 4; ++m) { const int row = row0 + ai * HALF + m * 16; const size_t off = (size_t)row * ldc + col0; float ss = 0.f;
#pragma unroll
                for (int bj = 0; bj < 2; ++bj) { const u32x4 xw = xb[m][bj];
                    const f32x4 x0 = (f32x4){bflo(xw.x), bfhi(xw.x), bflo(xw.y), bfhi(xw.y)} * rm[m] * ig[bj][0], x1 = (f32x4){bflo(xw.z), bfhi(xw.z), bflo(xw.w), bfhi(xw.w)} * rm[m] * ig[bj][1];
                    const f32x4 v0 = acc[ai][bj][m][0] * osc + x0, v1 = acc[ai][bj][m][1] * osc + x1;
                    u32x4 w; w.x = cvt_pk_bf16(v0[0], v0[1]); w.y = cvt_pk_bf16(v0[2], v0[3]); w.z = cvt_pk_bf16(v1[0], v1[1]); w.w = cvt_pk_bf16(v1[2], v1[3]);
                    *(u32x4*)(CB + off + bj * HALF) = w;
                    ss += (v0[0] * v0[0] + v0[1] * v0[1]) + (v0[2] * v0[2] + v0[3] * v0[3]) + (v1[0] * v1[0] + v1[1] * v1[1]) + (v1[2] * v1[2] + v1[3] * v1[3]); }
                ss += __shfl_xor(ss, 16); ss += __shfl_xor(ss, 32);
                if (fq == 0) sq[row] = ss; }
        }
    }
};
}

struct Frame {
    LAS unsigned char* lds;
    volatile LAS unsigned* MISC;
    gu32* ctl;
    int tid, lane, wave;
    int vcu, G;
    const float *x, *ln1g, *w_in, *rel_bias, *wg2, *bgate, *gng, *w_out, *ln2g, *w_q, *keys1, *keys2, *pu, *pv, *lnfg;
    float* out;
    bf16 *WinT, *WoutT, *WqT, *XN, *MIX, *HN, *PROJ, *PQ; unsigned char *U8, *V8;
    float *GA, *GATE, *LB, *SC, *SSQ, *RSTD, *RMS1; unsigned char *XQ8, *XN8, *WIN8, *MIX8, *WOUT8; int* IDX;
};

__device__ __forceinline__ float wave_sum(float v) {
#pragma unroll
    for (int o = 1; o < 64; o <<= 1) v += __shfl_xor(v, o);
    return v;
}
__device__ __forceinline__ float wave_max(float v) {
#pragma unroll
    for (int o = 1; o < 64; o <<= 1) v = fmaxf(v, __shfl_xor(v, o));
    return v;
}

__device__ __forceinline__ unsigned q8pack(float a, float b_, float c, float d) {
    const int qa = (int)__builtin_rintf(a), qb = (int)__builtin_rintf(b_), qc = (int)__builtin_rintf(c), qd = (int)__builtin_rintf(d);
    return ((unsigned)qa & 255u) | (((unsigned)qb & 255u) << 8) | (((unsigned)qc & 255u) << 16) | ((unsigned)qd << 24);
}
__device__ __forceinline__ void transpose_item(const float* W, int K, int N, bf16* WT, int src_n0, int dst_n0, int ncols, int k0, LAS float* scr, int lane, const float* gk = nullptr, unsigned char* WT8 = nullptr) {
    const int ch = lane & 7, kr = lane >> 3; const bool ok = 4 * ch < ncols;
#pragma unroll
    for (int i = 0; i < 8; ++i) { const int kk = 8 * i + kr; f32x4 v = {0.f, 0.f, 0.f, 0.f};
        if (ok) v = *(const GAS f32x4*)(W + (size_t)(k0 + kk) * N + src_n0 + 4 * ch);
        LAS float* d = scr + kk * 33 + 4 * ch; d[0] = v.x; d[1] = v.y; d[2] = v.z; d[3] = v.w; }
    LDS_WAIT(); asm volatile("" ::: "memory");
    const int c = lane & 7;
    f32x4 g0 = {1.f, 1.f, 1.f, 1.f}, g1 = g0;
    if (gk) { g0 = *(const GAS f32x4*)(gk + k0 + 8 * c); g1 = *(const GAS f32x4*)(gk + k0 + 8 * c + 4); }
#pragma unroll
    for (int j = 0; j < 4; ++j) { const int n = (lane >> 3) + 8 * j; const LAS float* s = scr + (8 * c) * 33 + n;
        v4u o; o.x = pk2(s[0 * 33] * g0.x, s[1 * 33] * g0.y); o.y = pk2(s[2 * 33] * g0.z, s[3 * 33] * g0.w); o.z = pk2(s[4 * 33] * g1.x, s[5 * 33] * g1.y); o.w = pk2(s[6 * 33] * g1.z, s[7 * 33] * g1.w);
        if (WT8) { int w0 = 0, w1 = 0;
            w0 = __builtin_amdgcn_cvt_pk_fp8_f32(s[0 * 33] * WIN8_SCALE, s[1 * 33] * WIN8_SCALE, w0, false); w0 = __builtin_amdgcn_cvt_pk_fp8_f32(s[2 * 33] * WIN8_SCALE, s[3 * 33] * WIN8_SCALE, w0, true);
            w1 = __builtin_amdgcn_cvt_pk_fp8_f32(s[4 * 33] * WIN8_SCALE, s[5 * 33] * WIN8_SCALE, w1, false); w1 = __builtin_amdgcn_cvt_pk_fp8_f32(s[6 * 33] * WIN8_SCALE, s[7 * 33] * WIN8_SCALE, w1, true);
            if (n < ncols) *(GAS v2u*)(WT8 + (size_t)(dst_n0 + n) * K + k0 + 8 * c) = (v2u){(unsigned)w0, (unsigned)w1}; }
        else if (n < ncols) *(GAS v4u*)(WT + (size_t)(dst_n0 + n) * K + k0 + 8 * c) = o; }
    LDS_WAIT(); asm volatile("" ::: "memory");
}
__device__ __forceinline__ void rms_row_to_bf16(const float* xrow, const f32x4 (&gv)[8], bf16* orow, int lane, float* rms_out, unsigned char* orow8) {
    const GAS f32x4* xr = (const GAS f32x4*)xrow + lane;
    f32x4 v[8]; float s = 0.f;
#pragma unroll
    for (int j = 0; j < 8; ++j) { v[j] = xr[64 * j]; s += (v[j].x * v[j].x + v[j].y * v[j].y) + (v[j].z * v[j].z + v[j].w * v[j].w); }
    const float rstd = rsqrtf(wave_sum(s) * (1.f / DM) + EPS);
    if (lane == 0) *rms_out = 1.f / rstd;
    GAS v2u* o8 = (GAS v2u*)orow + lane;
#pragma unroll
    for (int j = 0; j < 8; ++j) { const f32x4 gg = gv[j];
        const float y0 = v[j].x * rstd * gg.x, y1 = v[j].y * rstd * gg.y, y2 = v[j].z * rstd * gg.z, y3 = v[j].w * rstd * gg.w;
        v2u o; o.x = pk2(y0, y1); o.y = pk2(y2, y3); o8[64 * j] = o;
        int w8 = 0; w8 = __builtin_amdgcn_cvt_pk_fp8_f32(y0, y1, w8, false); w8 = __builtin_amdgcn_cvt_pk_fp8_f32(y2, y3, w8, true);
        *(GAS unsigned*)(orow8 + 256 * j + 4 * lane) = (unsigned)w8; }
}

__device__ __forceinline__ void p0_prologue(Frame& F) {
    LAS float* scr = (LAS float*)(F.lds + RING_OFF + F.wave * 16384);
    const int gw = F.vcu * NWAVES + F.wave, NGW = F.G * NWAVES;
    const int gtid = F.vcu * (NWAVES * 64) + F.tid, NT = F.G * NWAVES * 64;
    constexpr int KB = DM / 64;
    constexpr int NB_IN = 160 + 32 + 1;
    constexpr int I_IN = KB * NB_IN, I_O = KB * (DM / 32), I_Q = KB * (DM / 32);
    for (int it = gw; it < I_IN + I_O + I_Q; it += NGW) {
        int r = it;
        if (r < I_IN) { const int kb = r / NB_IN, nb = r % NB_IN; int s0, d0, nc = 32;
            if (nb < 160) { s0 = 32 * nb; d0 = s0; } else if (nb < 192) { s0 = 5136 + 32 * (nb - 160); d0 = 5120 + 32 * (nb - 160); } else { s0 = 5120; d0 = 6144; nc = 16; }
            transpose_item(F.w_in, DM, DIN, F.WinT, s0, d0, nc, 64 * kb, scr, F.lane, nullptr, (nb < 192 && is_f8_col(d0)) ? F.WIN8 : nullptr); continue; }
        r -= I_IN;
        if (r < I_O) { const int kb = r / (DM / 32), nb = r % (DM / 32); transpose_item(F.w_out, DM, DM, F.WoutT, 32 * nb, 32 * nb, 32, 64 * kb, scr, F.lane, nullptr, F.WOUT8); continue; }
        r -= I_O;
        { const int kb = r / (DM / 32), nb = r % (DM / 32); transpose_item(F.w_q, DM, DM, F.WqT, 32 * nb, 32 * nb, 32, 64 * kb, scr, F.lane, F.ln2g); }
    }
    f32x4 g2v[8];
#pragma unroll
    for (int j = 0; j < 8; ++j) g2v[j] = ((const GAS f32x4*)F.ln2g)[64 * j + F.lane];
    for (int row = gw; row < 2 * NEXP; row += NGW) {
        const bool isv = row >= NEXP; const int e = isv ? row - NEXP : row;
        const GAS f32x4* src = (const GAS f32x4*)((isv ? F.pv : F.pu) + (size_t)e * DM) + F.lane;
        f32x4 v[8]; float am = 0.f;
#pragma unroll
        for (int j = 0; j < 8; ++j) v[j] = src[64 * j];
#pragma unroll
        for (int j = 0; j < 8; ++j) { f32x4 t = v[j]; if (!isv) t = t * g2v[j];
            v[j] = t; am = fmaxf(am, fmaxf(fmaxf(fabsf(t.x), fabsf(t.y)), fmaxf(fabsf(t.z), fabsf(t.w)))); }
        am = wave_max(am);
        const float sc = fmaxf(am, 1e-30f) * (isv ? (1.f / 448.f) : (1.f / 127.f)), inv = 1.f / sc;
        unsigned char* tb = isv ? F.V8 : F.U8;
#pragma unroll
        for (int j = 0; j < 8; ++j) { const f32x4 t = v[j] * inv; int w = 0;
            if (isv) { w = __builtin_amdgcn_cvt_pk_fp8_f32(t.x, t.y, w, false); w = __builtin_amdgcn_cvt_pk_fp8_f32(t.z, t.w, w, true); }
            else w = (int)q8pack(t.x, t.y, t.z, t.w);
            *(GAS unsigned*)(tb + ((size_t)(2 * j + (F.lane >> 5)) * NEXP + e) * 128 + 4 * (F.lane & 31)) = (unsigned)w; }
        if (F.lane == 0) F.SC[row] = sc;
    }
    { f32x4 g1v[8];
#pragma unroll
      for (int j = 0; j < 8; ++j) g1v[j] = ((const GAS f32x4*)F.ln1g)[64 * j + F.lane];
      for (int m = gw; m < T; m += NGW) rms_row_to_bf16(F.x + (size_t)m * DM, g1v, F.XN + (size_t)m * DM, F.lane, F.RMS1 + m, F.XN8 + (size_t)m * DM); }
    for (int i = gtid; i < NH * SEQ; i += NT) {
        const int h = i >> 11, dist = i & 2047;
        const int cnt = (dist <= 128 ? 1 : 0) + (((dist & 3) == 0 && dist <= 512) ? 1 : 0) + (((dist & 15) == 0) ? 1 : 0);
        int bucket = dist;
        if (dist >= 16) { bucket = 16 + (int)(log((double)dist / 16.0) / log(128.0) * 16.0); if (bucket > 31) bucket = 31; }
        F.LB[i] = cnt ? F.rel_bias[bucket * NH + h] * LOG2E + log2f((float)cnt) : -1e30f;
    }
}

__device__ __forceinline__ void ga_mfma(Frame& F) {
    typedef float f32x4_t __attribute__((ext_vector_type(4)));
    const int gw = F.vcu * NWAVES + F.wave, NGW = F.G * NWAVES, lane = F.lane, r16 = lane & 15, kg = lane >> 4;
    for (int task = gw; task < T / 16; task += NGW) {
        const bf16* ap = F.XN + (size_t)(task * 16 + r16) * DM + 8 * kg;
        const bf16* bp = F.WinT + (size_t)(NPROJ + r16) * DM + 8 * kg;
        f32x4_t acc = {0.f, 0.f, 0.f, 0.f};
#pragma unroll 8
        for (int ks = 0; ks < DM / 32; ++ks) { const bf16x8 a = *(const GAS bf16x8*)(ap + 32 * ks), bb = *(const GAS bf16x8*)(bp + 32 * ks);
            acc = __builtin_amdgcn_mfma_f32_16x16x32_bf16(a, bb, acc, 0, 0, 0); }
#pragma unroll
        for (int r = 0; r < 4; ++r) F.GA[(size_t)(task * 16 + 4 * kg + r) * 16 + r16] = acc[r];
    }
}

namespace att {
typedef short s16x4 __attribute__((ext_vector_type(4)));
typedef short v4i16_t __attribute__((ext_vector_type(4)));
typedef float f32x16 __attribute__((ext_vector_type(16)));
typedef float f32x2_t __attribute__((ext_vector_type(2))); typedef __bf16 bf16x2_t __attribute__((ext_vector_type(2)));
__device__ __forceinline__ unsigned cvtpk(float lo, float hi) { f32x2_t v = {lo, hi}; bf16x2_t bb = __builtin_convertvector(v, bf16x2_t); return __builtin_bit_cast(unsigned, bb); }
__device__ __forceinline__ s16x4 vtr(const LAS unsigned char* p) { return __builtin_bit_cast(s16x4, __builtin_amdgcn_ds_read_tr16_b64_v4i16((LAS v4i16_t*)p)); }
__device__ __forceinline__ int crow(int r, int hi) { return (r & 3) + 8 * (r >> 2) + 4 * hi; }
constexpr int KST = 144, TILEB = 64 * KST;
constexpr int L_LB = 0, L_K = 9856, L_V = L_K + 2 * TILEB, L_WS = L_V + 2 * TILEB;
constexpr int N_UNITS = BATCH * NH * (SEQ / 256);
#define ATT_MFMA(a, b, c) __builtin_amdgcn_mfma_f32_32x32x16_bf16((a), (b), (c), 0, 0, 0)

__device__ __forceinline__ void attn_unit(Frame& F, int b, int hh, int qb) {
    LAS unsigned char* lds = F.lds;
    const int tid = F.tid, lane = F.lane, w = F.wave, r32 = lane & 31, hi = lane >> 5;
    const int q0 = qb * 256, NT = (q0 + 256) >> 6, nfar = qb > 2 ? qb - 2 : 0, kt0 = 4 * nfar;
    const int qposl = q0 + 2 * w + (r32 >> 4) + 16 * (r32 & 15);
    const size_t rowb = (size_t)b * SEQ;
    LAS float* LBs = (LAS float*)(lds + L_LB);
    __syncthreads();
    float lbv[5];
#pragma unroll
    for (int j = 0; j < 5; ++j) { const int i = tid + 512 * j; lbv[j] = (i >= 256 && i < 2304) ? F.LB[hh * SEQ + i - 256] : -1e30f; }
    bf16x8 qr[4];
    { const bf16* qp = F.PROJ + (rowb + qposl) * NPROJ + C_AQ + hh * 64 + hi * 8;
#pragma unroll
      for (int ks = 0; ks < 4; ++ks) qr[ks] = *(const GAS bf16x8*)(qp + 16 * ks); }
    const int srow = tid >> 3, sch = tid & 7;
    const bf16* kg = F.PROJ + (rowb + srow) * NPROJ + C_AK + hh * 64 + sch * 8;
    const bf16* vg = F.PROJ + (rowb + srow) * NPROJ + C_AV + hh * 64 + sch * 8;
    const int soff = srow * KST + sch * 16;
    v4u kreg = *(const GAS v4u*)(kg + (size_t)kt0 * 64 * NPROJ), vreg = *(const GAS v4u*)(vg + (size_t)kt0 * 64 * NPROJ);
    *(LAS v4u*)(lds + L_K + soff) = kreg; *(LAS v4u*)(lds + L_V + soff) = vreg;
#pragma unroll
    for (int j = 0; j < 5; ++j) { const int i = tid + 512 * j; if (i < 2304) LBs[i + (i >> 4)] = lbv[j]; }
    kreg = *(const GAS v4u*)(kg + (size_t)(kt0 + 1) * 64 * NPROJ); vreg = *(const GAS v4u*)(vg + (size_t)(kt0 + 1) * 64 * NPROJ);
    f32x16 o0, o1;
#pragma unroll
    for (int r = 0; r < 16; ++r) { o0[r] = 0.f; o1[r] = 0.f; }
    float mref = 0.f, l = 0.f;
    bool first = true;
    const int B0 = 256 + qposl - 4 * hi, nib = B0 & 15, Sd0 = B0 + (B0 >> 4);
    int bwm = 0;
#pragma unroll
    for (int mi = 0; mi < 8; ++mi) bwm |= ((nib < ((mi & 3) + 8 * (mi >> 2))) ? 1 : 0) << mi;
    const int bwf = (r32 >> 4) == 0 ? 1 : 0;
    LAS float* wsf = (LAS float*)(lds + L_WS + w * 256);
    LAS unsigned char* fv = lds + L_WS + 2048 + w * 4608;
    const int q4 = (lane & 15) >> 2, p4 = lane & 3, blk = (lane >> 4) & 1;
    const int voff = (4 * hi + q4) * KST + (16 * blk + 4 * p4) * 2;
    const int koff = r32 * KST + hi * 16;
    __syncthreads();
#pragma unroll 1
    for (int st = 0; st < nfar; ++st) {
        const int kb = 256 * st;
        bf16x8 ka[4]; v4u vv[4];
        { const bf16* kp = F.PROJ + (rowb + kb + 2 * w + (r32 >> 4) + 16 * (r32 & 15)) * NPROJ + C_AK + hh * 64 + hi * 8;
#pragma unroll
          for (int ks = 0; ks < 4; ++ks) ka[ks] = *(const GAS bf16x8*)(kp + 16 * ks);
          const int vr = lane >> 1, vh = lane & 1;
          const bf16* vpg = F.PROJ + (rowb + kb + 2 * w + (vr >> 4) + 16 * (vr & 15)) * NPROJ + C_AV + hh * 64 + 32 * vh;
#pragma unroll
          for (int i = 0; i < 4; ++i) vv[i] = *(const GAS v4u*)(vpg + 8 * i);
#pragma unroll
          for (int i = 0; i < 4; ++i) *(LAS v4u*)(fv + vr * KST + 64 * vh + 16 * i) = vv[i]; }
        f32x16 s0; const float ninit = -mref;
#pragma unroll
        for (int r = 0; r < 16; ++r) s0[r] = ninit;
#pragma unroll
        for (int ks = 0; ks < 4; ++ks) s0 = ATT_MFMA(ka[ks], qr[ks], s0);
        const int Bf = 256 + qposl - kb - 2 * w - 64 * hi; const LAS float* lbf = LBs + (Bf + (Bf >> 4));
        float tm = -3.0e38f;
        float bvf[16];
#pragma unroll
        for (int r = 0; r < 16; ++r) { const int off = (r >> 3) + 16 * (r & 3) + 128 * ((r >> 2) & 1); bvf[r] = lbf[-(off + (off >> 4)) - ((r >> 3) ? bwf : 0)]; }
        LDS_WAIT(); asm volatile("" ::: "memory");
#pragma unroll
        for (int r = 0; r < 16; ++r) { asm volatile("" : "+v"(bvf[r])); s0[r] += bvf[r]; tm = fmaxf(tm, s0[r]); }
        tm = fmaxf(tm, __shfl_xor(tm, 32));
        if (first || __any(tm > 8.f)) {
            const float d = first ? tm : fmaxf(tm, 0.f);
            mref += d; const float f = __builtin_amdgcn_exp2f(-d); l *= f;
#pragma unroll
            for (int r = 0; r < 16; ++r) s0[r] -= d;
            if (!first) {
                if (hi == 0) wsf[r32] = f;
                LDS_WAIT(); asm volatile("" ::: "memory");
#pragma unroll
                for (int r = 0; r < 16; ++r) { const float fr = wsf[crow(r, hi)]; o0[r] *= fr; o1[r] *= fr; }
                LDS_WAIT(); asm volatile("" ::: "memory");
            }
            first = false;
        }
        float ps = 0.f;
#pragma unroll
        for (int r = 0; r < 16; ++r) { s0[r] = __builtin_amdgcn_exp2f(s0[r]); ps += s0[r]; }
        l += ps;
        LDS_WAIT(); asm volatile("" ::: "memory");
#pragma unroll
        for (int s = 0; s < 2; ++s) {
            v4u pw; pw.x = cvtpk(s0[8 * s], s0[8 * s + 1]); pw.y = cvtpk(s0[8 * s + 2], s0[8 * s + 3]); pw.z = cvtpk(s0[8 * s + 4], s0[8 * s + 5]); pw.w = cvtpk(s0[8 * s + 6], s0[8 * s + 7]);
            const bf16x8 pa = __builtin_bit_cast(bf16x8, pw);
            const LAS unsigned char* vp = fv + voff + (16 * s) * KST;
            { const s16x4 lo = vtr(vp), hh2 = vtr(vp + 8 * KST); const bf16x8 vb = __builtin_shufflevector(lo, hh2, 0, 1, 2, 3, 4, 5, 6, 7); o0 = ATT_MFMA(pa, vb, o0); }
            { const s16x4 lo = vtr(vp + 64), hh2 = vtr(vp + 8 * KST + 64); const bf16x8 vb = __builtin_shufflevector(lo, hh2, 0, 1, 2, 3, 4, 5, 6, 7); o1 = ATT_MFMA(pa, vb, o1); }
        }
        LDS_WAIT(); asm volatile("" ::: "memory");
    }
    for (int kt = kt0; kt < NT; ++kt) {
        const int cur = kt & 1;
        {
            const LAS unsigned char* Kb = lds + L_K + cur * TILEB; const LAS unsigned char* Vb = lds + L_V + cur * TILEB;
            f32x16 s0, s1; const float ninit = -mref;
#pragma unroll
            for (int r = 0; r < 16; ++r) { s0[r] = ninit; s1[r] = ninit; }
#pragma unroll
            for (int ks = 0; ks < 4; ++ks) { const bf16x8 a0 = *(const LAS bf16x8*)(Kb + koff + ks * 32); const bf16x8 a1 = *(const LAS bf16x8*)(Kb + koff + 32 * KST + ks * 32);
                s0 = ATT_MFMA(a0, qr[ks], s0); s1 = ATT_MFMA(a1, qr[ks], s1); }
            const LAS float* lbp = LBs + (Sd0 - 68 * kt);
            float tm = -3.0e38f;
            float bv[16];
#pragma unroll
            for (int r = 0; r < 16; ++r) { const int c = (r & 3) + 8 * (r >> 2), mi = (r & 3) + 4 * ((r >> 2) & 1); bv[r] = lbp[-(c + (c >> 4)) - ((bwm >> mi) & 1)]; }
            LDS_WAIT(); asm volatile("" ::: "memory");
#pragma unroll
            for (int r = 0; r < 16; ++r) { asm volatile("" : "+v"(bv[r])); s0[r] += bv[r]; tm = fmaxf(tm, s0[r]); }
#pragma unroll
            for (int r = 0; r < 16; ++r) { const int c = (r & 3) + 8 * (r >> 2) + 32, mi = (r & 3) + 4 * ((r >> 2) & 1); bv[r] = lbp[-(c + (c >> 4)) - ((bwm >> mi) & 1)]; }
            LDS_WAIT(); asm volatile("" ::: "memory");
#pragma unroll
            for (int r = 0; r < 16; ++r) { asm volatile("" : "+v"(bv[r])); s1[r] += bv[r]; tm = fmaxf(tm, s1[r]); }
            tm = fmaxf(tm, __shfl_xor(tm, 32));
            if (first || __any(tm > 8.f)) {
                const float d = first ? tm : fmaxf(tm, 0.f);
                mref += d; const float f = __builtin_amdgcn_exp2f(-d); l *= f;
#pragma unroll
                for (int r = 0; r < 16; ++r) { s0[r] -= d; s1[r] -= d; }
                if (!first) {
                    if (hi == 0) wsf[r32] = f;
                    LDS_WAIT(); asm volatile("" ::: "memory");
#pragma unroll
                    for (int r = 0; r < 16; ++r) { const float fr = wsf[crow(r, hi)]; o0[r] *= fr; o1[r] *= fr; }
                    LDS_WAIT(); asm volatile("" ::: "memory");
                }
                first = false;
            }
            float ps = 0.f;
#pragma unroll
            for (int r = 0; r < 16; ++r) { s0[r] = __builtin_amdgcn_exp2f(s0[r]); s1[r] = __builtin_amdgcn_exp2f(s1[r]); ps += s0[r] + s1[r]; }
            l += ps;
#pragma unroll
            for (int mt = 0; mt < 2; ++mt)
#pragma unroll
                for (int s = 0; s < 2; ++s) {
                    v4u pw;
                    if (mt == 0) { pw.x = cvtpk(s0[8 * s], s0[8 * s + 1]); pw.y = cvtpk(s0[8 * s + 2], s0[8 * s + 3]); pw.z = cvtpk(s0[8 * s + 4], s0[8 * s + 5]); pw.w = cvtpk(s0[8 * s + 6], s0[8 * s + 7]); }
                    else { pw.x = cvtpk(s1[8 * s], s1[8 * s + 1]); pw.y = cvtpk(s1[8 * s + 2], s1[8 * s + 3]); pw.z = cvtpk(s1[8 * s + 4], s1[8 * s + 5]); pw.w = cvtpk(s1[8 * s + 6], s1[8 * s + 7]); }
                    const bf16x8 pa = __builtin_bit_cast(bf16x8, pw);
                    const LAS unsigned char* vp = Vb + voff + (32 * mt + 16 * s) * KST;
                    { const s16x4 lo = vtr(vp), hh2 = vtr(vp + 8 * KST); const bf16x8 vb = __builtin_shufflevector(lo, hh2, 0, 1, 2, 3, 4, 5, 6, 7); o0 = ATT_MFMA(pa, vb, o0); }
                    { const s16x4 lo = vtr(vp + 64), hh2 = vtr(vp + 8 * KST + 64); const bf16x8 vb = __builtin_shufflevector(lo, hh2, 0, 1, 2, 3, 4, 5, 6, 7); o1 = ATT_MFMA(pa, vb, o1); }
                }
        }
        if (kt + 1 < NT) {
            *(LAS v4u*)(lds + L_K + (cur ^ 1) * TILEB + soff) = kreg; *(LAS v4u*)(lds + L_V + (cur ^ 1) * TILEB + soff) = vreg;
            if (kt + 2 < NT) { kreg = *(const GAS v4u*)(kg + (size_t)(kt + 2) * 64 * NPROJ); vreg = *(const GAS v4u*)(vg + (size_t)(kt + 2) * 64 * NPROJ); }
        }
        __syncthreads();
    }
    { const float lt = l + __shfl_xor(l, 32); const float inv = 1.f / lt;
      if (hi == 0) wsf[r32] = inv;
      LDS_WAIT(); asm volatile("" ::: "memory");
      LAS unsigned char* ot = lds + L_K + w * 4608;
#pragma unroll
      for (int r = 0; r < 16; ++r) { const float fr = wsf[crow(r, hi)]; LAS unsigned short* orow_ = (LAS unsigned short*)(ot + crow(r, hi) * KST);
          orow_[r32] = (unsigned short)f2bf(o0[r] * fr); orow_[32 + r32] = (unsigned short)f2bf(o1[r] * fr); }
      LDS_WAIT(); asm volatile("" ::: "memory");
      { const int orw = lane >> 1, ohf = lane & 1; const LAS unsigned char* src = ot + orw * KST + 64 * ohf;
        unsigned char* op = F.MIX8 + (size_t)(rowb + q0 + 2 * w + (orw >> 4) + 16 * (orw & 15)) * DM + hh * 64 + 32 * ohf;
        const v4u a0_ = *(const LAS v4u*)src, a1_ = *(const LAS v4u*)(src + 16), a2_ = *(const LAS v4u*)(src + 32), a3_ = *(const LAS v4u*)(src + 48);
        v4u o0_, o1_; o0_.x = bf4_to_f8(a0_.x, a0_.y); o0_.y = bf4_to_f8(a0_.z, a0_.w); o0_.z = bf4_to_f8(a1_.x, a1_.y); o0_.w = bf4_to_f8(a1_.z, a1_.w);
        o1_.x = bf4_to_f8(a2_.x, a2_.y); o1_.y = bf4_to_f8(a2_.z, a2_.w); o1_.z = bf4_to_f8(a3_.x, a3_.y); o1_.w = bf4_to_f8(a3_.z, a3_.w);
        *(GAS v4u*)op = o0_; *(GAS v4u*)(op + 16) = o1_; }
      LDS_WAIT(); asm volatile("" ::: "memory"); }
}
template <class PostFn> __device__ __forceinline__ void attn_phase(Frame& F, gu32* qctr, int npre, PostFn post) {
    LAS int* uw = (LAS int*)(F.lds + 147456 - 1024);
    for (;;) {
        __syncthreads();
        if (F.tid == 0) *uw = (int)__hip_atomic_fetch_add(qctr, 1u, RLX_AGENT);
        __syncthreads();
        const int u0 = *uw;
        if (u0 >= npre + N_UNITS) break;
        if (u0 < npre) { post(u0); continue; }
        const int u = u0 - npre;
        const int qb = 7 - (u >> 7), bh = u & 127;
        attn_unit(F, bh >> 4, bh & 15, qb);
    }
}
}


namespace gla {
using att::f32x16; using att::s16x4; using att::vtr; using att::cvtpk; using att::crow;
constexpr int L_LA = 0;
constexpr int QST = 272;
constexpr int L_QT = 32768, L_QH = L_QT + 64 * QST, L_KH = L_QH + 64 * QST, L_KD = L_KH + 64 * QST;
constexpr int L_OST = L_QT, OSTF = 260;
constexpr int L_VS = 102400, VST = 528;
constexpr int L_SEG = 136192, L_DEC = L_SEG + 2048, L_GN = L_DEC + 512, L_END = L_GN + 1024;
constexpr int AST = 144;
#define GLA_MFMA(a, b, c) __builtin_amdgcn_mfma_f32_32x32x16_bf16((a), (b), (c), 0, 0, 0)
__device__ __forceinline__ bf16x8 pack8(const f32x16& x, int s) {
    v4u p; p.x = cvtpk(x[8 * s], x[8 * s + 1]); p.y = cvtpk(x[8 * s + 2], x[8 * s + 3]); p.z = cvtpk(x[8 * s + 4], x[8 * s + 5]); p.w = cvtpk(x[8 * s + 6], x[8 * s + 7]);
    return __builtin_bit_cast(bf16x8, p);
}
constexpr int REC_QT = 0, REC_AT = 64 * QST, REC_BYTES = REC_AT + 64 * AST;
constexpr size_t SCR_REC = 0, SCR_DEC = 28 * MiB, SCR_KV = 32 * MiB;
constexpr int NITEM = BATCH * NGH * (SEQ / 64);
constexpr int REC_PIECES = REC_BYTES / 16;
__device__ __forceinline__ void gla_pre_item(Frame& F, int b, int h, int n, int item) {
    LAS unsigned char* lds = F.lds;
    const int tid = F.tid, lane = F.lane, w = F.wave, r32 = lane & 31, hi = lane >> 5;
    const size_t rowb = (size_t)b * SEQ;
    const int gmt = w & 1, gnt = w >> 1;
    const int pt = tid >> 3, ps = tid & 7;
    LAS float* LA = (LAS float*)(lds + L_LA); LAS float* SEG = (LAS float*)(lds + L_SEG); LAS float* DEC = (LAS float*)(lds + L_DEC);
    bf16x8 wgf;
    { v4u t;
      t.x = pk2(F.wg2[(8 * hi + 0) * 512 + h * 128 + 32 * gnt + r32], F.wg2[(8 * hi + 1) * 512 + h * 128 + 32 * gnt + r32]);
      t.y = pk2(F.wg2[(8 * hi + 2) * 512 + h * 128 + 32 * gnt + r32], F.wg2[(8 * hi + 3) * 512 + h * 128 + 32 * gnt + r32]);
      t.z = pk2(F.wg2[(8 * hi + 4) * 512 + h * 128 + 32 * gnt + r32], F.wg2[(8 * hi + 5) * 512 + h * 128 + 32 * gnt + r32]);
      t.w = pk2(F.wg2[(8 * hi + 6) * 512 + h * 128 + 32 * gnt + r32], F.wg2[(8 * hi + 7) * 512 + h * 128 + 32 * gnt + r32]);
      wgf = __builtin_bit_cast(bf16x8, t); }
    const float gbias = F.bgate[h * 128 + 32 * gnt + r32];
    v4u pq[2], pk[2], pv[4]; f32x4 pga[2];
    { const float* ga_ = F.GA + (rowb + 64 * n + 32 * gmt + r32) * 16 + 8 * hi; pga[0] = *(const GAS f32x4*)ga_; pga[1] = *(const GAS f32x4*)(ga_ + 4);
      const bf16* pr_ = F.PROJ + (rowb + 64 * n + pt) * NPROJ;
      pq[0] = *(const GAS v4u*)(pr_ + C_GQ + h * 128 + 16 * ps); pq[1] = *(const GAS v4u*)(pr_ + C_GQ + h * 128 + 16 * ps + 8);
      pk[0] = *(const GAS v4u*)(pr_ + C_GK + h * 128 + 16 * ps); pk[1] = *(const GAS v4u*)(pr_ + C_GK + h * 128 + 16 * ps + 8);
#pragma unroll
      for (int i = 0; i < 4; ++i) pv[i] = *(const GAS v4u*)(pr_ + C_GV + h * 256 + 32 * ps + 8 * i); }
    { v4u ap; ap.x = pk2(pga[0].x, pga[0].y); ap.y = pk2(pga[0].z, pga[0].w); ap.z = pk2(pga[1].x, pga[1].y); ap.w = pk2(pga[1].z, pga[1].w);
      f32x16 z;
#pragma unroll
      for (int r = 0; r < 16; ++r) z[r] = 0.f;
      z = GLA_MFMA(__builtin_bit_cast(bf16x8, ap), wgf, z);
#pragma unroll
      for (int r = 0; r < 16; ++r) { float lg = z[r] + gbias; lg = fminf(fmaxf(lg, -80.f), 80.f);
          const float la2 = -__builtin_amdgcn_logf(1.f + __builtin_amdgcn_exp2f(-lg * LOG2E)) * (1.f / 16.f);
          LA[(32 * gmt + crow(r, hi)) * 128 + 32 * gnt + r32] = la2; } }
    __syncthreads();
    { const int c = tid & 127, seg = tid >> 7; float run = 0.f;
#pragma unroll
      for (int i = 0; i < 16; ++i) { run += LA[(16 * seg + i) * 128 + c]; LA[(16 * seg + i) * 128 + c] = run; }
      SEG[seg * 128 + c] = run; }
    __syncthreads();
    { const int c0 = 16 * ps, sg = pt >> 4;
      const int ro = pt * QST + c0 * 2;
#pragma unroll
      for (int i = 0; i < 4; ++i) {
          const f32x4 bb = *(const LAS f32x4*)(LA + pt * 128 + c0 + 4 * i);
          const f32x4 s0 = *(const LAS f32x4*)(SEG + c0 + 4 * i), s1 = *(const LAS f32x4*)(SEG + 128 + c0 + 4 * i), s2 = *(const LAS f32x4*)(SEG + 256 + c0 + 4 * i), s3 = *(const LAS f32x4*)(SEG + 384 + c0 + 4 * i);
          const f32x4 l31 = *(const LAS f32x4*)(LA + 31 * 128 + c0 + 4 * i);
          f32x4 pre = {0.f, 0.f, 0.f, 0.f}; if (sg > 0) pre += s0; if (sg > 1) pre += s1; if (sg > 2) pre += s2;
          const f32x4 bv = bb + pre, bref = l31 + s0, blast = (s0 + s1) + (s2 + s3);
          const unsigned qw0_ = (i < 2) ? (i == 0 ? pq[0].x : pq[0].z) : (i == 2 ? pq[1].x : pq[1].z), qw1_ = (i < 2) ? (i == 0 ? pq[0].y : pq[0].w) : (i == 2 ? pq[1].y : pq[1].w);
          const unsigned kw0_ = (i < 2) ? (i == 0 ? pk[0].x : pk[0].z) : (i == 2 ? pk[1].x : pk[1].z), kw1_ = (i < 2) ? (i == 0 ? pk[0].y : pk[0].w) : (i == 2 ? pk[1].y : pk[1].w);
          const float qv[4] = {bflo(qw0_) * GQSCALE, bfhi(qw0_) * GQSCALE, bflo(qw1_) * GQSCALE, bfhi(qw1_) * GQSCALE};
          const float kv[4] = {bflo(kw0_), bfhi(kw0_), bflo(kw1_), bfhi(kw1_)};
          float a_[4], b_[4], c_[4], d_[4];
#pragma unroll
          for (int e = 0; e < 4; ++e) { const float eb = __builtin_amdgcn_exp2f(bv[e]), e1 = __builtin_amdgcn_exp2f(bv[e] - bref[e]), e2 = __builtin_amdgcn_exp2f(bref[e] - bv[e]), e3 = __builtin_amdgcn_exp2f(blast[e] - bv[e]);
              a_[e] = qv[e] * eb; b_[e] = qv[e] * e1; c_[e] = kv[e] * e2; d_[e] = kv[e] * e3; }
          *(LAS v2u*)(lds + L_QT + ro + 8 * i) = (v2u){cvtpk(a_[0], a_[1]), cvtpk(a_[2], a_[3])}; *(LAS v2u*)(lds + L_QH + ro + 8 * i) = (v2u){cvtpk(b_[0], b_[1]), cvtpk(b_[2], b_[3])};
          *(LAS v2u*)(lds + L_KH + ro + 8 * i) = (v2u){cvtpk(c_[0], c_[1]), cvtpk(c_[2], c_[3])}; *(LAS v2u*)(lds + L_KD + ro + 8 * i) = (v2u){cvtpk(d_[0], d_[1]), cvtpk(d_[2], d_[3])};
          __builtin_amdgcn_sched_barrier(0);
          if (pt == 0) { f32x4 dv; dv.x = __builtin_amdgcn_exp2f(blast.x); dv.y = __builtin_amdgcn_exp2f(blast.y); dv.z = __builtin_amdgcn_exp2f(blast.z); dv.w = __builtin_amdgcn_exp2f(blast.w); *(LAS f32x4*)(DEC + c0 + 4 * i) = dv; }
      }
#pragma unroll
      for (int i = 0; i < 4; ++i) *(LAS v4u*)(lds + L_VS + pt * VST + 64 * ps + 16 * i) = pv[i]; }
    __syncthreads();
    if (w < 3) { const int jt = (w == 2) ? 1 : 0, it = (w >= 1) ? 1 : 0;
        f32x16 x;
#pragma unroll
        for (int r = 0; r < 16; ++r) x[r] = 0.f;
#pragma unroll
        for (int ks = 0; ks < 8; ++ks) { const bf16x8 a = *(const LAS bf16x8*)(lds + L_KH + (32 * jt + r32) * QST + (16 * ks + 8 * hi) * 2);
            const bf16x8 bq = *(const LAS bf16x8*)(lds + L_QH + (32 * it + r32) * QST + (16 * ks + 8 * hi) * 2); x = GLA_MFMA(a, bq, x); }
        const int i = 32 * it + r32;
#pragma unroll
        for (int g = 0; g < 4; ++g) { const int j0 = 32 * jt + 8 * g + 4 * hi;
            const float v0 = (j0 + 0 <= i) ? x[4 * g + 0] : 0.f, v1 = (j0 + 1 <= i) ? x[4 * g + 1] : 0.f, v2 = (j0 + 2 <= i) ? x[4 * g + 2] : 0.f, v3 = (j0 + 3 <= i) ? x[4 * g + 3] : 0.f;
            v2u pw; pw.x = cvtpk(v0, v1); pw.y = cvtpk(v2, v3); *(LAS v2u*)(lds + L_LA + i * AST + j0 * 2) = pw; }
    } else if (w == 3) { const v4u zz = {0u, 0u, 0u, 0u}; *(LAS v4u*)(lds + L_LA + r32 * AST + 64 + hi * 32) = zz; *(LAS v4u*)(lds + L_LA + r32 * AST + 64 + hi * 32 + 16) = zz; }
    __syncthreads();
    { const int q4 = (lane & 15) >> 2, p4 = lane & 3, blk = (lane >> 4) & 1;
      unsigned char* kvp = (unsigned char*)F.out + SCR_KV + (size_t)item * (256 * 128 * 2) + (size_t)(32 * w + r32) * 256;
      bf16x8 vf[4];
#pragma unroll
      for (int s = 0; s < 4; ++s) { const LAS unsigned char* vp_ = lds + L_VS + (16 * s + 8 * hi + q4) * VST + (32 * w + 16 * blk + 4 * p4) * 2; const s16x4 lo_ = vtr(vp_), hi_ = vtr(vp_ + 4 * VST); vf[s] = __builtin_shufflevector(lo_, hi_, 0, 1, 2, 3, 4, 5, 6, 7); }
#pragma unroll
      for (int ct = 0; ct < 4; ++ct) { f32x16 acc;
#pragma unroll
          for (int r = 0; r < 16; ++r) acc[r] = 0.f;
#pragma unroll
          for (int s = 0; s < 4; ++s) { const LAS unsigned char* kp = lds + L_KD + (16 * s + 8 * hi + q4) * QST + (32 * ct + 16 * blk + 4 * p4) * 2;
              const s16x4 lo = vtr(kp), hh2 = vtr(kp + 4 * QST); const bf16x8 af = __builtin_shufflevector(lo, hh2, 0, 1, 2, 3, 4, 5, 6, 7); acc = GLA_MFMA(af, vf[s], acc); }
#pragma unroll
          for (int g = 0; g < 4; ++g) { v2u pw; pw.x = cvtpk(acc[4 * g], acc[4 * g + 1]); pw.y = cvtpk(acc[4 * g + 2], acc[4 * g + 3]); *(GAS v2u*)(kvp + (32 * ct + 8 * g + 4 * hi) * 2) = pw; } } }
    { unsigned char* rec = (unsigned char*)F.out + SCR_REC + (size_t)item * REC_BYTES;
      for (int p = tid; p < REC_BYTES / 16; p += 512) { const int off = p * 16; const int src = off < REC_AT ? (L_QT + off) : (L_LA + off - REC_AT); *(GAS v4u*)(rec + off) = *(const LAS v4u*)(lds + src); }
      if (tid < 32) *(GAS f32x4*)((unsigned char*)F.out + SCR_DEC + (size_t)item * 512 + tid * 16) = *(const LAS f32x4*)(lds + L_DEC + tid * 16); }
    __syncthreads();
}
__device__ __forceinline__ void gla_scan(Frame& F) {
#pragma unroll 1
    for (int g = F.vcu * (NWAVES * 64) + F.tid; g < BATCH * NGH * 4096; g += F.G * NWAVES * 64) {
        const int bh = g >> 12, piece = g & 4095, c8 = (piece & 15) * 8;
        unsigned char* kv = (unsigned char*)F.out + SCR_KV + (size_t)bh * (SEQ / 64) * (256 * 128 * 2) + (size_t)piece * 16;
        const unsigned char* dc = (const unsigned char*)F.out + SCR_DEC + (size_t)bh * (SEQ / 64) * 512 + c8 * 4;
        float st[8];
#pragma unroll
        for (int j = 0; j < 8; ++j) st[j] = 0.f;
#pragma unroll 8
        for (int n = 0; n < SEQ / 64; ++n) {
            const v4u kw = *(const GAS v4u*)(kv + (size_t)n * (256 * 128 * 2));
            const f32x4 d0 = *(const GAS f32x4*)(dc + n * 512), d1 = *(const GAS f32x4*)(dc + n * 512 + 16);
            v4u ow; ow.x = cvtpk(st[0], st[1]); ow.y = cvtpk(st[2], st[3]); ow.z = cvtpk(st[4], st[5]); ow.w = cvtpk(st[6], st[7]);
            *(GAS v4u*)(kv + (size_t)n * (256 * 128 * 2)) = ow;
            st[0] = d0.x * st[0] + bflo(kw.x); st[1] = d0.y * st[1] + bfhi(kw.x); st[2] = d0.z * st[2] + bflo(kw.y); st[3] = d0.w * st[3] + bfhi(kw.y);
            st[4] = d1.x * st[4] + bflo(kw.z); st[5] = d1.y * st[5] + bfhi(kw.z); st[6] = d1.z * st[6] + bflo(kw.w); st[7] = d1.w * st[7] + bfhi(kw.w);
        }
    }
}
constexpr int P_REC = 0, P_VS = REC_BYTES, P_OST = P_VS + 64 * VST, P_GN = P_OST + 64 * OSTF * 4, P_END = P_GN + 1024;
__device__ __forceinline__ void gla_post_item(Frame& F, int b, int h, int n, int item) {
    LAS unsigned char* lds = F.lds;
    const int tid = F.tid, lane = F.lane, w = F.wave, r32 = lane & 31, hi = lane >> 5, q4 = (lane & 15) >> 2, p4 = lane & 3, blk = (lane >> 4) & 1, pt = tid >> 3, ps = tid & 7;
    const size_t rowb = (size_t)b * SEQ;
    LAS float* OST = (LAS float*)(lds + P_OST);
    __syncthreads();
    bf16x8 sf[8];
    { const unsigned char* sp = (const unsigned char*)F.out + SCR_KV + (size_t)item * (256 * 128 * 2) + (size_t)(32 * w + r32) * 256 + 16 * hi;
#pragma unroll
      for (int ks = 0; ks < 8; ++ks) sf[ks] = *(const GAS bf16x8*)(sp + 32 * ks); }
    { const unsigned char* rec = (const unsigned char*)F.out + SCR_REC + (size_t)item * REC_BYTES;
      v4u rc_[4];
#pragma unroll
      for (int k = 0; k < 4; ++k) { const int p = tid + 512 * k; rc_[k] = (p < REC_BYTES / 16) ? *(const GAS v4u*)(rec + p * 16) : (v4u){0u, 0u, 0u, 0u}; }
#pragma unroll
      for (int k = 0; k < 4; ++k) { const int p = tid + 512 * k; if (p < REC_BYTES / 16) *(LAS v4u*)(lds + P_REC + p * 16) = rc_[k]; }
      const bf16* pr_ = F.PROJ + (rowb + 64 * n + pt) * NPROJ;
#pragma unroll
      for (int i = 0; i < 4; ++i) *(LAS v4u*)(lds + P_VS + pt * VST + 64 * ps + 16 * i) = *(const GAS v4u*)(pr_ + C_GV + h * 256 + 32 * ps + 8 * i);
      if (tid < 256) ((LAS float*)(lds + P_GN))[tid] = F.gng[h * 256 + tid]; }
    v4u gr_[4];
    { const bf16* pr_ = F.PROJ + (rowb + 64 * n + pt) * NPROJ + C_GR + h * 256 + 32 * ps;
#pragma unroll
      for (int i = 0; i < 4; ++i) gr_[i] = *(const GAS v4u*)(pr_ + 8 * i); }
    __syncthreads();
    f32x16 o0, o1;
#pragma unroll
    for (int r = 0; r < 16; ++r) { o0[r] = 0.f; o1[r] = 0.f; }
#pragma unroll
    for (int ks = 0; ks < 8; ++ks) {
        const bf16x8 a0 = *(const LAS bf16x8*)(lds + P_REC + REC_QT + r32 * QST + (16 * ks + 8 * hi) * 2), a1 = *(const LAS bf16x8*)(lds + P_REC + REC_QT + (32 + r32) * QST + (16 * ks + 8 * hi) * 2);
        o0 = GLA_MFMA(a0, sf[ks], o0); o1 = GLA_MFMA(a1, sf[ks], o1); }
#pragma unroll
    for (int s = 0; s < 4; ++s) {
        const LAS unsigned char* vp_ = lds + P_VS + (16 * s + 8 * hi + q4) * VST + (32 * w + 16 * blk + 4 * p4) * 2; const s16x4 lo_ = vtr(vp_), hi_ = vtr(vp_ + 4 * VST);
        const bf16x8 vf = __builtin_shufflevector(lo_, hi_, 0, 1, 2, 3, 4, 5, 6, 7);
        if (s < 2) { const bf16x8 a = *(const LAS bf16x8*)(lds + P_REC + REC_AT + r32 * AST + (16 * s + 8 * hi) * 2); o0 = GLA_MFMA(a, vf, o0); }
        { const bf16x8 a = *(const LAS bf16x8*)(lds + P_REC + REC_AT + (32 + r32) * AST + (16 * s + 8 * hi) * 2); o1 = GLA_MFMA(a, vf, o1); }
    }
#pragma unroll
    for (int r = 0; r < 16; ++r) { OST[crow(r, hi) * OSTF + 32 * w + r32] = o0[r]; OST[(32 + crow(r, hi)) * OSTF + 32 * w + r32] = o1[r]; }
    __syncthreads();
    { f32x4 ov[8]; float ss = 0.f;
#pragma unroll
      for (int i = 0; i < 8; ++i) { ov[i] = *(const LAS f32x4*)(OST + pt * OSTF + 32 * ps + 4 * i); ss += (ov[i].x * ov[i].x + ov[i].y * ov[i].y) + (ov[i].z * ov[i].z + ov[i].w * ov[i].w); }
      ss += __shfl_xor(ss, 1); ss += __shfl_xor(ss, 2); ss += __shfl_xor(ss, 4);
      const float rstd = rsqrtf(ss * (1.f / 256.f) + EPS);
      unsigned char* op = F.MIX8 + (size_t)(rowb + 64 * n + pt) * DM + 1024 + h * 256 + 32 * ps;
      const LAS float* gp = (const LAS float*)(lds + P_GN) + 32 * ps;
#pragma unroll
      for (int i = 0; i < 4; ++i) { const f32x4 g0 = *(const LAS f32x4*)(gp + 8 * i), g1 = *(const LAS f32x4*)(gp + 8 * i + 4); const v4u gw = gr_[i];
          float y[8]; const float grv[8] = {bflo(gw.x), bfhi(gw.x), bflo(gw.y), bfhi(gw.y), bflo(gw.z), bfhi(gw.z), bflo(gw.w), bfhi(gw.w)};
          const float ovv[8] = {ov[2 * i].x, ov[2 * i].y, ov[2 * i].z, ov[2 * i].w, ov[2 * i + 1].x, ov[2 * i + 1].y, ov[2 * i + 1].z, ov[2 * i + 1].w};
          const float gg[8] = {g0.x, g0.y, g0.z, g0.w, g1.x, g1.y, g1.z, g1.w};
#pragma unroll
          for (int e = 0; e < 8; ++e) { const float sil = grv[e] * __builtin_amdgcn_rcpf(1.f + __builtin_amdgcn_exp2f(-grv[e] * LOG2E)); y[e] = ovv[e] * rstd * gg[e] * sil; }
          int w0 = 0, w1 = 0; w0 = __builtin_amdgcn_cvt_pk_fp8_f32(y[0] * MIX8_SCALE, y[1] * MIX8_SCALE, w0, false); w0 = __builtin_amdgcn_cvt_pk_fp8_f32(y[2] * MIX8_SCALE, y[3] * MIX8_SCALE, w0, true);
          w1 = __builtin_amdgcn_cvt_pk_fp8_f32(y[4] * MIX8_SCALE, y[5] * MIX8_SCALE, w1, false); w1 = __builtin_amdgcn_cvt_pk_fp8_f32(y[6] * MIX8_SCALE, y[7] * MIX8_SCALE, w1, true);
          *(GAS v2u*)(op + 8 * i) = (v2u){(unsigned)w0, (unsigned)w1}; } }
}
}

namespace pks {
using att::f32x16; using att::crow;
constexpr int KROW = 272;
constexpr int L_K1 = 0, L_K2 = 128 * KROW, L_TAB = 2 * 128 * KROW;
#define PK_MFMA(a, b, c) __builtin_amdgcn_mfma_f32_32x32x16_bf16((a), (b), (c), 0, 0, 0)
#define PK_CE(a, b) do { const float hi_ = fmaxf((a), (b)), lo_ = fminf((a), (b)); (a) = hi_; (b) = lo_; } while (0)
__device__ __forceinline__ void sort16(float (&x)[16]) {
#pragma unroll
    for (int k = 2; k <= 16; k <<= 1)
#pragma unroll
        for (int j = k >> 1; j > 0; j >>= 1)
#pragma unroll
            for (int i = 0; i < 16; ++i) { const int l = i ^ j; if (l > i) { if ((i & k) == 0) PK_CE(x[i], x[l]); else PK_CE(x[l], x[i]); } }
}
__device__ __forceinline__ void merge16(float (&t)[16], const float (&g)[16]) {
#pragma unroll
    for (int i = 0; i < 16; ++i) t[i] = fmaxf(t[i], g[15 - i]);
#pragma unroll
    for (int j = 8; j > 0; j >>= 1)
#pragma unroll
        for (int i = 0; i < 16; ++i) { const int l = i ^ j; if (l > i) PK_CE(t[i], t[l]); }
}
__device__ __forceinline__ float packid(float v, unsigned id, unsigned mask) { return __builtin_bit_cast(float, (__builtin_bit_cast(unsigned, v) & ~mask) | id); }
__device__ __forceinline__ float clearid(float v, unsigned mask) { return __builtin_bit_cast(float, __builtin_bit_cast(unsigned, v) & ~mask); }
__device__ __forceinline__ void set_top16(Frame& F, const bf16* qbase, int ktab, float (&T)[16], int lane) {
    const int r32 = lane & 31, hi = lane >> 5;
    f32x16 acc[4];
#pragma unroll
    for (int mt = 0; mt < 4; ++mt)
#pragma unroll
        for (int r = 0; r < 16; ++r) acc[mt][r] = 0.f;
#pragma unroll
    for (int ks = 0; ks < 8; ++ks) {
        const bf16x8 qf = *(const GAS bf16x8*)(qbase + 16 * ks + 8 * hi);
#pragma unroll
        for (int mt = 0; mt < 4; ++mt) { const bf16x8 kf = *(const LAS bf16x8*)(F.lds + ktab + (32 * mt + r32) * KROW + (16 * ks + 8 * hi) * 2); acc[mt] = PK_MFMA(kf, qf, acc[mt]); }
    }
    float g[16];
#pragma unroll
    for (int mt = 0; mt < 4; ++mt) {
#pragma unroll
        for (int r = 0; r < 16; ++r) g[r] = packid(acc[mt][r], (unsigned)(32 * mt + crow(r, hi)), 127u);
        sort16(g);
        if (mt == 0) {
#pragma unroll
            for (int r = 0; r < 16; ++r) T[r] = g[r];
        } else merge16(T, g);
    }
#pragma unroll
    for (int r = 0; r < 16; ++r) g[r] = __shfl_xor(T[r], 32);
    merge16(T, g);
}
__device__ __forceinline__ void peer_score(Frame& F) {
    const int tid = F.tid, lane = F.lane, w = F.wave, r32 = lane & 31, hi = lane >> 5;
    { f32x4 kv_[16];
#pragma unroll
      for (int j = 0; j < 16; ++j) { const int i = tid + 512 * j, s = i >> 12, row = (i >> 5) & 127, c4 = i & 31; kv_[j] = *(const GAS f32x4*)((s ? F.keys2 : F.keys1) + row * 128 + 4 * c4); }
#pragma unroll
      for (int j = 0; j < 16; ++j) { const int i = tid + 512 * j, s = i >> 12, row = (i >> 5) & 127, c4 = i & 31; const f32x4 v = kv_[j];
        v2u o; o.x = pk2(v.x, v.y); o.y = pk2(v.z, v.w); *(LAS v2u*)(F.lds + (s ? L_K2 : L_K1) + row * KROW + 8 * c4) = o; } }
    __syncthreads();
    LAS unsigned char* tab = F.lds + L_TAB + w * 2304 + lane * 36;
    const float NEG = -3.0e38f;
    for (int task = 2 * (int)blockIdx.x * PEH + w; task < (T / 32) * PEH; task += (task & 8) ? (2 * F.G - 1) * PEH : PEH) {
        const int tg = task >> 3, hp = task & 7; const int m = tg * 32 + r32;
        const bf16* q = F.PQ + (size_t)m * DM + hp * 256;
        float rstd;
        { float s_ = 0.f;
#pragma unroll
          for (int k = 0; k < 16; ++k) s_ += F.SSQ[(size_t)(16 * hi + k) * T + m];
          s_ += __shfl_xor(s_, 32); rstd = rsqrtf(s_ * (1.f / DM) + EPS); if (hp == 0 && hi == 0) F.RSTD[m] = rstd; }
        float T1[16], T2[16];
        set_top16(F, q, L_K1, T1, lane);
        set_top16(F, q + 128, L_K2, T2, lane);
        { v4u a, c;
          a.x = (__builtin_bit_cast(unsigned, T1[0]) & 127u) | ((__builtin_bit_cast(unsigned, T1[1]) & 127u) << 8) | ((__builtin_bit_cast(unsigned, T1[2]) & 127u) << 16) | ((__builtin_bit_cast(unsigned, T1[3]) & 127u) << 24);
          a.y = (__builtin_bit_cast(unsigned, T1[4]) & 127u) | ((__builtin_bit_cast(unsigned, T1[5]) & 127u) << 8) | ((__builtin_bit_cast(unsigned, T1[6]) & 127u) << 16) | ((__builtin_bit_cast(unsigned, T1[7]) & 127u) << 24);
          a.z = (__builtin_bit_cast(unsigned, T1[8]) & 127u) | ((__builtin_bit_cast(unsigned, T1[9]) & 127u) << 8) | ((__builtin_bit_cast(unsigned, T1[10]) & 127u) << 16) | ((__builtin_bit_cast(unsigned, T1[11]) & 127u) << 24);
          a.w = (__builtin_bit_cast(unsigned, T1[12]) & 127u) | ((__builtin_bit_cast(unsigned, T1[13]) & 127u) << 8) | ((__builtin_bit_cast(unsigned, T1[14]) & 127u) << 16) | ((__builtin_bit_cast(unsigned, T1[15]) & 127u) << 24);
          c.x = (__builtin_bit_cast(unsigned, T2[0]) & 127u) | ((__builtin_bit_cast(unsigned, T2[1]) & 127u) << 8) | ((__builtin_bit_cast(unsigned, T2[2]) & 127u) << 16) | ((__builtin_bit_cast(unsigned, T2[3]) & 127u) << 24);
          c.y = (__builtin_bit_cast(unsigned, T2[4]) & 127u) | ((__builtin_bit_cast(unsigned, T2[5]) & 127u) << 8) | ((__builtin_bit_cast(unsigned, T2[6]) & 127u) << 16) | ((__builtin_bit_cast(unsigned, T2[7]) & 127u) << 24);
          c.z = (__builtin_bit_cast(unsigned, T2[8]) & 127u) | ((__builtin_bit_cast(unsigned, T2[9]) & 127u) << 8) | ((__builtin_bit_cast(unsigned, T2[10]) & 127u) << 16) | ((__builtin_bit_cast(unsigned, T2[11]) & 127u) << 24);
          c.w = (__builtin_bit_cast(unsigned, T2[12]) & 127u) | ((__builtin_bit_cast(unsigned, T2[13]) & 127u) << 8) | ((__builtin_bit_cast(unsigned, T2[14]) & 127u) << 16) | ((__builtin_bit_cast(unsigned, T2[15]) & 127u) << 24);
          LAS unsigned* tw = (LAS unsigned*)tab;
          tw[0] = a.x; tw[1] = a.y; tw[2] = a.z; tw[3] = a.w; tw[4] = c.x; tw[5] = c.y; tw[6] = c.z; tw[7] = c.w; }
        float a_[16], b_[16];
#pragma unroll
        for (int i = 0; i < 16; ++i) { a_[i] = clearid(T1[i], 127u); b_[i] = clearid(T2[i], 127u); }
        float C[16], G[16];
#pragma unroll
        for (int j = 0; j < 16; ++j) C[j] = packid(a_[0] + b_[j], (unsigned)j, 255u);
        { int n = 0;
#pragma unroll
          for (int j = 0; j < 8; ++j) G[n++] = packid(a_[1] + b_[j], 16u + j, 255u);
#pragma unroll
          for (int j = 0; j < 5; ++j) G[n++] = packid(a_[2] + b_[j], 32u + j, 255u);
#pragma unroll
          for (int j = 0; j < 3; ++j) G[n++] = packid(a_[3] + b_[j], 48u + j, 255u);
          sort16(G); merge16(C, G); }
        { int n = 0;
          G[n++] = packid(a_[3] + b_[3], 48u + 3u, 255u);
#pragma unroll
          for (int j = 0; j < 3; ++j) G[n++] = packid(a_[4] + b_[j], 64u + j, 255u);
#pragma unroll
          for (int i = 5; i < 8; ++i) { G[n++] = packid(a_[i] + b_[0], 16u * i, 255u); G[n++] = packid(a_[i] + b_[1], 16u * i + 1u, 255u); }
#pragma unroll
          for (int i = 8; i < 14; ++i) G[n++] = packid(a_[i] + b_[0], 16u * i, 255u);
          sort16(G); merge16(C, G); }
        {
          G[0] = packid(a_[14] + b_[0], 16u * 14u, 255u); G[1] = packid(a_[15] + b_[0], 16u * 15u, 255u); if (G[1] > G[0]) { const float t_ = G[0]; G[0] = G[1]; G[1] = t_; }
#pragma unroll
          for (int i = 2; i < 16; ++i) G[i] = NEG;
          merge16(C, G); }
        const float mx = clearid(C[0], 255u);
        float e[16], sum = 0.f;
#pragma unroll
        for (int k = 0; k < 16; ++k) { e[k] = __builtin_amdgcn_exp2f((clearid(C[k], 255u) - mx) * (LOG2E * rstd)); sum += e[k]; }
        const float inv = 1.f / sum;
        LDS_WAIT(); asm volatile("" ::: "memory");
        int eo[8]; float go[8];
        { int k1_[8], k2_[8];
#pragma unroll
          for (int kk = 0; kk < 8; ++kk) { const float cv = hi ? C[8 + kk] : C[kk]; const unsigned id = __builtin_bit_cast(unsigned, cv) & 255u; k1_[kk] = tab[id >> 4]; k2_[kk] = tab[16 + (id & 15)]; }
          LDS_WAIT(); asm volatile("" ::: "memory");
#pragma unroll
          for (int kk = 0; kk < 8; ++kk) { asm volatile("" : "+v"(k1_[kk]), "+v"(k2_[kk])); eo[kk] = k1_[kk] * PEK + k2_[kk]; go[kk] = (hi ? e[8 + kk] : e[kk]) * inv; } }
        int* ip = F.IDX + (size_t)m * 128 + hp * 16 + 8 * hi; float* gp = F.GATE + (size_t)m * 128 + hp * 16 + 8 * hi;
        *(GAS v4u*)ip = (v4u){(unsigned)eo[0], (unsigned)eo[1], (unsigned)eo[2], (unsigned)eo[3]}; *(GAS v4u*)(ip + 4) = (v4u){(unsigned)eo[4], (unsigned)eo[5], (unsigned)eo[6], (unsigned)eo[7]};
        *(GAS f32x4*)gp = (f32x4){go[0], go[1], go[2], go[3]}; *(GAS f32x4*)(gp + 4) = (f32x4){go[4], go[5], go[6], go[7]};
        LDS_WAIT(); asm volatile("" ::: "memory");
    }
}
}

typedef float f32x2 __attribute__((ext_vector_type(2)));
__device__ __forceinline__ float gelu_erf(float v) {
    const float av = fabsf(v), t = __builtin_amdgcn_rcpf(av * 0.2316418882f + 1.0f);
    float q = t * 0.5307027145f + (-0.7265760135f); q = q * t + 0.7107068705f; q = q * t + (-0.142248368f); q = q * t + 0.127414796f; q = q * t;
    const float e = __builtin_amdgcn_exp2f((v * v) * (-0.72134752044f));
    const float mm = v * (q * e);
    return v < 0.f ? mm : v - mm;
}
namespace pex {
constexpr int L_IDX = 0, L_H = 32768, L_SS = 65536, L_RS = 81920, L_XS = 82176;
#define PX_DPP(v, ctrl) __builtin_bit_cast(float, __builtin_amdgcn_update_dpp(0, __builtin_bit_cast(int, (v)), (ctrl), 0xF, 0xF, true))
__device__ __forceinline__ float red8(float v) { v += PX_DPP(v, 0xB1); v += PX_DPP(v, 0x4E); v += PX_DPP(v, 0x141); return v; }
__device__ __forceinline__ float redpg(float v) {
    v += PX_DPP(v, 0x128); v += __shfl_xor(v, 16); v += __shfl_xor(v, 32);
    return v;
}
#define PX_CVT(w_, hi_) __builtin_amdgcn_cvt_pk_f32_fp8((int)(w_), (hi_))
__device__ __forceinline__ void peer_experts(Frame& F) {
    const int tid = F.tid, lane = F.lane, w = F.wave, seg = lane & 7, pg = lane >> 3;
    LAS unsigned* IDX2 = (LAS unsigned*)(F.lds + L_IDX); LAS float* H2 = (LAS float*)(F.lds + L_H); LAS float* SSL = (LAS float*)(F.lds + L_SS); LAS float* RSL = (LAS float*)(F.lds + L_RS);
    const bf16* HN = F.HN;
    for (int tile = (int)blockIdx.x; tile < T / 64; tile += F.G) {
        const int m0 = tile * 64;
        for (int i = tid; i < 64 * 64; i += 512) SSL[i] = 0.f;
        { int iv_[16];
#pragma unroll
          for (int j = 0; j < 16; ++j) iv_[j] = F.IDX[(size_t)m0 * 128 + tid + 512 * j];
#pragma unroll
          for (int j = 0; j < 16; ++j) { const int i = tid + 512 * j, t = i >> 7, p = i & 127; IDX2[t * 128 + (p & 7) * 16 + (p >> 3)] = (unsigned)iv_[j] * 128u; } }
        if (tid < 64) RSL[tid] = F.RSTD[m0 + tid];
        { LAS float* XSL = (LAS float*)(F.lds + L_XS);
#pragma unroll 1
          for (int hb = 0; hb < 2; ++hb) {
            v4u rw[4][4];
#pragma unroll
            for (int t4 = 0; t4 < 4; ++t4)
#pragma unroll
                for (int i = 0; i < 4; ++i) rw[t4][i] = *(const GAS v4u*)((const unsigned char*)(HN + (size_t)(m0 + 8 * w + 4 * hb + t4) * DM) + 64 * lane + 16 * i);
#pragma unroll
            for (int t4 = 0; t4 < 4; ++t4) { float am = 0.f;
#pragma unroll
                for (int i = 0; i < 4; ++i) { const v4u q = rw[t4][i];
                    am = fmaxf(am, fmaxf(fmaxf(fmaxf(fabsf(bflo(q.x)), fabsf(bfhi(q.x))), fmaxf(fabsf(bflo(q.y)), fabsf(bfhi(q.y)))), fmaxf(fmaxf(fabsf(bflo(q.z)), fabsf(bfhi(q.z))), fmaxf(fabsf(bflo(q.w)), fabsf(bfhi(q.w)))))); }
                am = wave_max(am);
                const float xs = fmaxf(am, 1e-30f) * (1.f / 127.f), xi = 1.f / xs;
                v4u o[2];
#pragma unroll
                for (int i = 0; i < 4; ++i) { const v4u q = rw[t4][i];
                    const unsigned lo = q8pack(bflo(q.x) * xi, bfhi(q.x) * xi, bflo(q.y) * xi, bfhi(q.y) * xi), hi2 = q8pack(bflo(q.z) * xi, bfhi(q.z) * xi, bflo(q.w) * xi, bfhi(q.w) * xi);
                    if (i == 0) { o[0].x = lo; o[0].y = hi2; } else if (i == 1) { o[0].z = lo; o[0].w = hi2; } else if (i == 2) { o[1].x = lo; o[1].y = hi2; } else { o[1].z = lo; o[1].w = hi2; } }
                unsigned char* qrow = F.XQ8 + (size_t)(m0 + 8 * w + 4 * hb + t4) * DM + 32 * lane;
                *(GAS v4u*)qrow = o[0]; *(GAS v4u*)(qrow + 16) = o[1];
                if (lane == 0) XSL[8 * w + 4 * hb + t4] = xs; } }
          asm volatile("s_waitcnt vmcnt(0)" ::: "memory"); }
        __syncthreads();
        v4u RA[8], RB[8], XA[2], XB[2];
        const bool sb0 = (seg & 1) != 0, sb1 = (seg & 2) != 0, sb2 = (seg & 4) != 0, pb0 = (pg & 1) != 0, pb1 = (pg & 2) != 0, pb2 = (pg & 4) != 0;
        const int krev = 4 * (seg & 1) + (seg & 2) + ((seg >> 2) & 1), jcol = 8 * (pg & 1) + 2 * (pg & 2) + ((pg >> 1) & 2);
        const unsigned seg16 = 16u * seg, seg32 = 32u * seg, seg64 = 64u * seg; const int pg4 = 4 * pg;
#define PX_LOAD8(TB, R, s_, tt_, hf_) do { const unsigned char* b_ = (TB) + (size_t)(s_) * NEXP * 128; const LAS v4u* ip_ = (const LAS v4u*)(IDX2 + (8 * w + (tt_)) * 128 + 8 * (hf_)) + pg4; \
            const v4u i0_ = ip_[0] + seg16, i1_ = ip_[1] + seg16; \
            R[0] = *(const GAS v4u*)(b_ + i0_.x); R[1] = *(const GAS v4u*)(b_ + i0_.y); R[2] = *(const GAS v4u*)(b_ + i0_.z); R[3] = *(const GAS v4u*)(b_ + i0_.w); \
            R[4] = *(const GAS v4u*)(b_ + i1_.x); R[5] = *(const GAS v4u*)(b_ + i1_.y); R[6] = *(const GAS v4u*)(b_ + i1_.z); R[7] = *(const GAS v4u*)(b_ + i1_.w); } while (0)
#define PX_LOADX(X, s_, tt_) do { X[0] = *(const GAS v4u*)(F.XQ8 + (size_t)(m0 + 8 * w + (tt_)) * DM + 128 * (s_) + seg16); } while (0)
        for (int i = tid; i < 64 * 128; i += 512) H2[i] = 0.f;
        __syncthreads();
#define PX_DOT8(R, XC_, own_) do { float d_[8]; \
            _Pragma("unroll") for (int k = 0; k < 8; ++k) { int a_ = __builtin_amdgcn_sdot4((int)R[k].x, (int)XC_[0].x, 0, false); a_ = __builtin_amdgcn_sdot4((int)R[k].y, (int)XC_[0].y, a_, false); \
                a_ = __builtin_amdgcn_sdot4((int)R[k].z, (int)XC_[0].z, a_, false); a_ = __builtin_amdgcn_sdot4((int)R[k].w, (int)XC_[0].w, a_, false); d_[k] = (float)a_; } \
            float e_[4], f_[2]; \
            _Pragma("unroll") for (int k = 0; k < 4; ++k) { const float snd_ = sb0 ? d_[k] : d_[k + 4], kp_ = sb0 ? d_[k + 4] : d_[k]; e_[k] = kp_ + PX_DPP(snd_, 0xB1); } \
            _Pragma("unroll") for (int k = 0; k < 2; ++k) { const float snd_ = sb1 ? e_[k] : e_[k + 2], kp_ = sb1 ? e_[k + 2] : e_[k]; f_[k] = kp_ + PX_DPP(snd_, 0x4E); } \
            { const float snd_ = sb2 ? f_[0] : f_[1], kp_ = sb2 ? f_[1] : f_[0]; own_ = kp_ + __shfl_xor(snd_, 4); } \
            __builtin_amdgcn_sched_barrier(0); } while (0)
#define PX_TOK1(tt, XC, XN_) do { PX_LOAD8(F.U8, RB, s, (tt), 1); __builtin_amdgcn_sched_barrier(0); \
            float own0_, own1_; \
            PX_DOT8(RA, XC, own0_); \
            { const int tn_ = ((tt) + 1) & 7, sn_ = s + (((tt) + 1) >> 3); if (sn_ < 16) { PX_LOAD8(F.U8, RA, sn_, tn_, 0); PX_LOADX(XN_, sn_, tn_); } } \
            __builtin_amdgcn_sched_barrier(0); PX_DOT8(RB, XC, own1_); \
            { LAS float* hp2_ = H2 + (8 * w + (tt)) * 128 + pg * 16 + krev; hp2_[0] += own0_; hp2_[8] += own1_; } } while (0)
        PX_LOAD8(F.U8, RA, 0, 0, 0); PX_LOADX(XA, 0, 0);
#pragma unroll 1
        for (int s = 0; s < 16; ++s) {
#pragma unroll 1
            for (int tp = 0; tp < 8; tp += 2) { PX_TOK1(tp, XA, XB); PX_TOK1(tp + 1, XB, XA); }
        }
#undef PX_TOK1
#undef PX_DOT8
        LDS_WAIT(); asm volatile("" ::: "memory");
        { float su_[16], sv_[16], gt_[16];
#pragma unroll
          for (int q = 0; q < 16; ++q) { const int t = 8 * w + (q >> 1), ii = krev + 8 * (q & 1), p = 8 * ii + pg; const int e = (int)(IDX2[t * 128 + pg * 16 + ii] >> 7);
              su_[q] = F.SC[e] * (RSL[t] * ((LAS float*)(F.lds + L_XS))[t]); sv_[q] = F.SC[NEXP + e]; gt_[q] = F.GATE[(size_t)(m0 + t) * 128 + p]; }
#pragma unroll
          for (int q = 0; q < 16; ++q) { const int t = 8 * w + (q >> 1), ii = krev + 8 * (q & 1); LAS float* hp = H2 + t * 128 + pg * 16 + ii; *hp = gelu_erf(*hp * su_[q]) * (gt_[q] * sv_[q]); } }
        LDS_WAIT(); asm volatile("" ::: "memory");
#define PX_AXPY8(R, tt_, hf_) do { const LAS f32x4* wp_ = (const LAS f32x4*)(H2 + (8 * w + (tt_)) * 128 + 8 * (hf_)) + pg4; const f32x4 w0_ = wp_[0], w1_ = wp_[1]; \
            const float wv_[8] = {w0_.x, w0_.y, w0_.z, w0_.w, w1_.x, w1_.y, w1_.z, w1_.w}; \
            _Pragma("unroll") for (int k = 0; k < 8; ++k) { const f32x2 w2v_ = {wv_[k], wv_[k]}; \
                acc_[0] += PX_CVT(R[k].x, false) * w2v_; acc_[1] += PX_CVT(R[k].x, true) * w2v_; acc_[2] += PX_CVT(R[k].y, false) * w2v_; acc_[3] += PX_CVT(R[k].y, true) * w2v_; \
                acc_[4] += PX_CVT(R[k].z, false) * w2v_; acc_[5] += PX_CVT(R[k].z, true) * w2v_; acc_[6] += PX_CVT(R[k].w, false) * w2v_; acc_[7] += PX_CVT(R[k].w, true) * w2v_; } \
            __builtin_amdgcn_sched_barrier(0); } while (0)
#define PX_TOK2(tt) do { const unsigned hb_ = *(const GAS unsigned*)((const unsigned char*)(HN + (size_t)(m0 + 8 * w + (tt)) * DM + 128 * s) + seg32 + 2u * jcol);     \
            PX_LOAD8(F.V8, RB, s, (tt), 1); __builtin_amdgcn_sched_barrier(0); \
            f32x2 acc_[8]; _Pragma("unroll") for (int k = 0; k < 8; ++k) acc_[k] = (f32x2){0.f, 0.f}; \
            PX_AXPY8(RA, (tt), 0); \
            { const int tn_ = ((tt) + 1) & 7, sn_ = s + (((tt) + 1) >> 3); if (sn_ < 16) PX_LOAD8(F.V8, RA, sn_, tn_, 0); } \
            __builtin_amdgcn_sched_barrier(0); PX_AXPY8(RB, (tt), 1); \
            const int t_ = 8 * w + (tt); \
            float v_[16], e_[8], f_[4], g_[2]; \
            _Pragma("unroll") for (int k = 0; k < 8; ++k) { v_[2 * k] = acc_[k].x; v_[2 * k + 1] = acc_[k].y; } \
            _Pragma("unroll") for (int j = 0; j < 8; ++j) { const float snd_ = pb0 ? v_[j] : v_[j + 8], kp_ = pb0 ? v_[j + 8] : v_[j]; e_[j] = kp_ + PX_DPP(snd_, 0x128); } \
            _Pragma("unroll") for (int j = 0; j < 4; ++j) { const float snd_ = pb1 ? e_[j] : e_[j + 4], kp_ = pb1 ? e_[j + 4] : e_[j]; f_[j] = kp_ + __shfl_xor(snd_, 16); } \
            _Pragma("unroll") for (int j = 0; j < 2; ++j) { const float snd_ = pb2 ? f_[j] : f_[j + 2], kp_ = pb2 ? f_[j + 2] : f_[j]; g_[j] = kp_ + __shfl_xor(snd_, 32); } \
            { unsigned char* ob_ = (unsigned char*)(F.out + (size_t)(m0 + t_) * DM + 128 * s); \
              f32x2 a_ = {bflo(hb_) + g_[0], bfhi(hb_) + g_[1]}; *(GAS f32x2*)(ob_ + seg64 + 4u * jcol) = a_; \
              SSL[t_ * 64 + lane] += a_.x * a_.x + a_.y * a_.y; } \
            __builtin_amdgcn_sched_barrier(0); } while (0)
        PX_LOAD8(F.V8, RA, 0, 0, 0);
#pragma unroll 1
        for (int s = 0; s < 16; ++s) {
#pragma unroll 1
            for (int tp = 0; tp < 8; ++tp) { PX_TOK2(tp); }
        }
#undef PX_TOK2
#undef PX_LOAD8
#undef PX_LOADX
#undef PX_AXPY8
        LDS_WAIT(); asm volatile("s_waitcnt vmcnt(0)" ::: "memory");
        { f32x4 an[8], gfv[8];
#pragma unroll
          for (int k = 0; k < 8; ++k) gfv[k] = *(const GAS f32x4*)(F.lnfg + 256 * k + 4 * lane);
#pragma unroll
          for (int k = 0; k < 8; ++k) an[k] = *((const GAS f32x4*)(F.out + (size_t)(m0 + 8 * w) * DM + 256 * k + 4 * lane));
#pragma unroll 1
          for (int tt = 0; tt < 8; ++tt) { const int t = 8 * w + tt; const float rstd = rsqrtf(wave_sum(SSL[t * 64 + lane]) * (1.f / DM) + EPS);
            float* orow = F.out + (size_t)(m0 + t) * DM; f32x4 a[8];
#pragma unroll
            for (int k = 0; k < 8; ++k) a[k] = an[k];
            if (tt + 1 < 8) {
#pragma unroll
                for (int k = 0; k < 8; ++k) an[k] = *((const GAS f32x4*)(orow + DM + 256 * k + 4 * lane)); }
#pragma unroll
            for (int k = 0; k < 8; ++k) { const f32x4 gg = gfv[k];
                a[k].x *= rstd * gg.x; a[k].y *= rstd * gg.y; a[k].z *= rstd * gg.z; a[k].w *= rstd * gg.w; *(GAS f32x4*)(orow + 256 * k + 4 * lane) = a[k]; } } }
        __syncthreads();
    }
}
}

struct Args { const float* in[15]; float* out; unsigned char* ws; int ph_lo, ph_hi; };
__global__ void __launch_bounds__(NWAVES * 64, 2) fwd(Args args) {
    extern __shared__ __attribute__((aligned(16))) unsigned char lds[];
    Frame F;
    F.lds = (LAS unsigned char*)lds;
    F.MISC = (volatile LAS unsigned*)(F.lds + MISC_OFF);
    F.tid = threadIdx.x; F.lane = F.tid & 63; F.wave = __builtin_amdgcn_readfirstlane(F.tid >> 6);
    F.G = gridDim.x; { const int bx = blockIdx.x; F.vcu = (F.G % 8 == 0) ? (bx % 8) * (F.G / 8) + bx / 8 : bx; }
    unsigned char* ws = args.ws;
    F.ctl = (gu32*)(ws + WS_CTL);
    F.x = args.in[0]; F.ln1g = args.in[1]; F.w_in = args.in[2]; F.rel_bias = args.in[3]; F.wg2 = args.in[4]; F.bgate = args.in[5]; F.gng = args.in[6]; F.w_out = args.in[7];
    F.ln2g = args.in[8]; F.w_q = args.in[9]; F.keys1 = args.in[10]; F.keys2 = args.in[11]; F.pu = args.in[12]; F.pv = args.in[13]; F.lnfg = args.in[14]; F.out = args.out;
    F.WinT = (bf16*)(ws + WS_WIN); F.WoutT = (bf16*)(ws + WS_WOUT); F.WqT = (bf16*)(ws + WS_WQ); F.XN = (bf16*)(ws + WS_XN); F.MIX = (bf16*)(ws + WS_MIX); F.HN = (bf16*)(ws + WS_HN); F.PROJ = (bf16*)(ws + WS_PROJ); F.PQ = (bf16*)(ws + WS_PROJ);
    F.U8 = ws + WS_U; F.V8 = ws + WS_V; F.SC = (float*)(ws + WS_SC); F.GA = (float*)(ws + WS_GA); F.IDX = (int*)(ws + WS_IDX); F.GATE = (float*)(ws + WS_GATE); F.LB = (float*)(ws + WS_LB); F.SSQ = (float*)(ws + WS_SSQ); F.RSTD = (float*)(ws + WS_RSTD); F.RMS1 = (float*)(ws + WS_RMS1); F.XQ8 = ws + WS_XQ8; F.XN8 = ws + WS_XN8; F.WIN8 = ws + WS_WIN8; F.MIX8 = ws + WS_MIX8; F.WOUT8 = ws + WS_WOUT8;
    for (int u = F.tid; u < (LDS_BYTES - LDSCTL_OFF) / 4; u += NWAVES * 64) ((LAS unsigned*)(F.lds + LDSCTL_OFF))[u] = 0u;
    __syncthreads();
    XcdBarrier bar; bar.bar = (unsigned*)(F.ctl + CW_BAR); bar.x = 0; bar.st = nullptr;
    if (N_LAUNCHES != PER_PHASE) bar = xcd_barrier_post((unsigned*)(F.ctl + CW_BAR), F.MISC + 8);
#define GRID_BAR(seam) do { if (N_LAUNCHES == PER_PHASE) { if (F.tid == 0) __hip_atomic_store(F.ctl + CW_TMO, 0xBADBA0u | (unsigned)(seam), RLX_AGENT); } else { xcd_barrier(bar); } } while (0)
    const int lo = args.ph_lo, hi = args.ph_hi;
#define IN(k) (lo <= (k) && (k) < hi)
#define BOTH(k) (IN(k) && IN((k) + 1))

    if (IN(0)) { p0_prologue(F); if (BOTH(0)) GRID_BAR(0); }

    if (IN(1)) {
        ga_mfma(F);
        __syncthreads();
        { pg8::Gemm g{(const pg8::bf16_t*)F.XN8, (const pg8::bf16_t*)F.WIN8, T, F8_A1 - F8_A0, DM / 2}; pg8::StaticOrder S; S.init(T, F8_A1 - F8_A0, F.G, (int)blockIdx.x);
          pg8::EpiProj E{F.PROJ, NPROJ, 1.f / WIN8_SCALE, F8_A0 / 256};
          pg8::gemm_phase<pg8::EpiProj, pg8::StaticOrder, true, true, true>(F.lds + RING_OFF, g, S, E); }
        __syncthreads();
        { pg8::Gemm g{F.XN, F.WinT + (size_t)F8_A1 * DM, T, F8_B0 - F8_A1, DM}; pg8::StaticOrder S; S.init(T, F8_B0 - F8_A1, F.G, (int)blockIdx.x);
          pg8::EpiProj E{F.PROJ, NPROJ, 1.f, F8_A1 / 256};
          pg8::gemm_phase<pg8::EpiProj, pg8::StaticOrder, true, true, false>(F.lds + RING_OFF, g, S, E); }
        __syncthreads();
        { pg8::Gemm g{(const pg8::bf16_t*)F.XN8, (const pg8::bf16_t*)(F.WIN8 + (size_t)F8_B0 * DM), T, F8_B1 - F8_B0, DM / 2}; pg8::StaticOrder S; S.init(T, F8_B1 - F8_B0, F.G, (int)blockIdx.x);
          pg8::EpiProj E{F.PROJ, NPROJ, 1.f / WIN8_SCALE, F8_B0 / 256};
          pg8::gemm_phase<pg8::EpiProj, pg8::StaticOrder, true, true, true>(F.lds + RING_OFF, g, S, E); }
        if (BOTH(1)) GRID_BAR(1);
    }

    if (IN(2)) {
        for (int it = F.vcu; it < gla::NITEM; it += F.G) gla::gla_pre_item(F, it >> 7, (it >> 5) & 3, it & 31, it);
        GRID_BAR(8);
        gla::gla_scan(F);
        GRID_BAR(9);
        att::attn_phase(F, F.ctl + CW_ATTQ, gla::NITEM, [&](int it) { gla::gla_post_item(F, it >> 7, (it >> 5) & 3, it & 31, it); });
        if (BOTH(2)) GRID_BAR(2);
    }

    if (IN(3)) {
        pg8::Gemm g{(const pg8::bf16_t*)F.MIX8, (const pg8::bf16_t*)F.WOUT8, T, DM, DM / 2}; pg8::StaticOrder S; S.init(T, DM, F.G, (int)blockIdx.x);
        pg8::EpiRes2 E{(const pg8::bf16_t*)F.XN, F.RMS1, F.ln1g, (pg8::bf16_t*)F.HN, F.SSQ, DM, T, 1.f / (WIN8_SCALE * MIX8_SCALE)};
        pg8::gemm_phase<pg8::EpiRes2, pg8::StaticOrder, true, true, true>(F.lds + RING_OFF, g, S, E);
        if (IN(5)) GRID_BAR(3);
    }


    if (IN(5)) {
        pg8::Gemm g{F.HN, F.WqT, T, DM, DM}; pg8::StaticOrder S; S.init(T, DM, F.G, (int)blockIdx.x);
        pg8::EpiBf16<0> E{F.PQ, DM, nullptr, 0, 0, 1.f};
        pg8::gemm_phase<pg8::EpiBf16<0>, pg8::StaticOrder, true, true>(F.lds + RING_OFF, g, S, E);
        if (BOTH(5)) GRID_BAR(5);
    }

    if (IN(6)) { pks::peer_score(F); if (BOTH(6)) { asm volatile("s_waitcnt vmcnt(0)" ::: "memory"); __syncthreads(); } }

    if (IN(7)) { pex::peer_experts(F); }
#undef IN
#undef BOTH
}

extern "C" void kernel_launch(void* const* d_in, const int* in_sizes, int n_in, void* d_out, int out_size, void* d_ws, size_t ws_size, hipStream_t stream) {
    static int grid = 0;
    if (grid == 0) {
        if (n_in != 15 || in_sizes[0] != T * DM || out_size != T * DM || ws_size < WS_END) { fprintf(stderr, "kernel_launch: unexpected shapes (n_in %d in0 %d out %d ws %zu)\n", n_in, n_in > 0 ? in_sizes[0] : -1, out_size, ws_size); grid = -1; return; }
        int dev = 0, cus = 0, per_cu = 0;
        if (hipGetDevice(&dev) != hipSuccess || hipDeviceGetAttribute(&cus, hipDeviceAttributeMultiprocessorCount, dev) != hipSuccess) { grid = -1; return; }
        if (hipFuncSetAttribute((const void*)fwd, hipFuncAttributeMaxDynamicSharedMemorySize, LDS_BYTES) != hipSuccess) { fprintf(stderr, "kernel_launch: hipFuncSetAttribute failed\n"); grid = -1; return; }
        if (hipOccupancyMaxActiveBlocksPerMultiprocessor(&per_cu, (const void*)fwd, NWAVES * 64, LDS_BYTES) != hipSuccess || per_cu < 1) fprintf(stderr, "kernel_launch: occupancy query reports %d\n", per_cu);
        (void)hipGetLastError();
        grid = cus;
    }
    if (grid < 0) return;
    if (hipMemsetAsync((char*)d_ws + WS_CTL, 0, CTL_ZERO_BYTES, stream) != hipSuccess) return;
    Args a{};
    for (int i = 0; i < 15; ++i) a.in[i] = (const float*)d_in[i];
    a.out = (float*)d_out; a.ws = (unsigned char*)d_ws;
    for (int li = 0; li < N_LAUNCHES; ++li) {
        a.ph_lo = (N_LAUNCHES == PER_PHASE) ? li : 0; a.ph_hi = (N_LAUNCHES == PER_PHASE) ? li + 1 : PER_PHASE;
        hipLaunchKernelGGL(fwd, dim3(grid), dim3(NWAVES * 64), LDS_BYTES, stream, a);
        const hipError_t le = hipPeekAtLastError();
        if (le != hipSuccess) { fprintf(stderr, "kernel_launch: launch %d failed: %s\n", li, hipGetErrorName(le)); break; }
    }
}
```

```cpp
#include <hip/hip_runtime.h>
#include <cstdio>
#include <cstdint>
#include <cmath>
namespace pg8 {
#define PG8_LAS __attribute__((address_space(3)))
typedef unsigned short bf16_t;
typedef short bf16x8 __attribute__((ext_vector_type(8)));
typedef float f32x4 __attribute__((ext_vector_type(4)));
typedef unsigned u32x4 __attribute__((ext_vector_type(4)));
constexpr int BM = 256, BK = 64, HALF = 128, HTB = HALF * BK * 2  , STAGE_BYTES = 8 * HTB, NXCD = 8, WGM = 8;

__host__ __device__ __forceinline__ int lds_byte(int r, int c) { const int st = (r >> 4) * 2 + (c >> 5), rr = r & 15, cc = c & 31, ob = rr * 64 + cc * 2; return st * 1024 + (ob ^ (((ob >> 9) & 1) << 5)); }
__host__ __device__ __forceinline__ void stage_rc(int b, int& R, int& C) { const int st = b / 1024, sb = b % 1024, swz = sb ^ (((sb >> 9) & 1) << 5); R = (st >> 1) * 16 + swz / 64; C = (st & 1) * 32 + (swz % 64) / 2; }
__host__ __device__ __forceinline__ int perm32(int rho) { const int n = rho >> 4, i = rho & 15; return 8 * (i >> 2) + 4 * n + (i & 3); }

struct Unit { int pm, pn; };
struct Gemm { const bf16_t* A; const bf16_t* Bt; int M, N, K; };

struct StaticOrder {
    int nM, nN, nwg, G, c;
    __host__ __device__ void init(int M, int N, int G_, int c_) { nM = M / BM; nN = N / BM; nwg = nM * nN; G = G_; c = c_; }
    __host__ __device__ bool next(int i, Unit& u) const {
        const long L = (long)i * G + c; if (L >= nwg) return false;
        int wgid = (int)L; { const int q = nwg / NXCD, r = nwg % NXCD, xcd = wgid % NXCD, off = wgid / NXCD; wgid = (xcd < r ? xcd * (q + 1) : r * (q + 1) + (xcd - r) * q) + off; }
        const int nig = WGM * nN, gid = wgid / nig, fm = gid * WGM, gsz = (nM - fm) < WGM ? (nM - fm) : WGM;
        u.pm = fm + ((wgid % nig) % gsz); u.pn = (wgid % nig) / gsz; return true;
    }
    __device__ __forceinline__ void a_ready(const Unit&) const {}
    __device__ __forceinline__ void done(const Unit&) const {}
};

__device__ __forceinline__ unsigned cvt_pk_bf16(float lo, float hi) { unsigned r; asm volatile("v_cvt_pk_bf16_f32 %0, %1, %2" : "=v"(r) : "v"(lo), "v"(hi)); return r; }
typedef float f32x2 __attribute__((ext_vector_type(2)));
__device__ __forceinline__ f32x2 gelu_pk(f32x2 v) {
    const f32x2 av = __builtin_elementwise_abs(v), d = av * 0.2316418882f + 1.0f;
    f32x2 t; t.x = __builtin_amdgcn_rcpf(d.x); t.y = __builtin_amdgcn_rcpf(d.y);
    f32x2 q = t * 0.5307027145f + (-0.7265760135f); q = q * t + 0.7107068705f; q = q * t + (-0.142248368f); q = q * t + 0.127414796f; q = q * t;
    const f32x2 s = (v * v) * (-0.72134752044f);
    f32x2 e; e.x = __builtin_amdgcn_exp2f(s.x); e.y = __builtin_amdgcn_exp2f(s.y);
    const f32x2 m = v * (q * e), r = v - m;
    f32x2 o; o.x = v.x < 0.f ? m.x : r.x; o.y = v.y < 0.f ? m.y : r.y; return o;
}

template <int ACT  > struct EpiBf16 {
    static constexpr bool PERM = true, AFTER_DRAIN = false; static_assert(ACT == 0 || ACT == 1, "EpiBf16: ACT is 0 (none) or 1 (gelu_pk)");
    bf16_t* O; int ldc; const float* bias; int split_cols; size_t split_stride; float scale0;
    __device__ __forceinline__ void operator()(const f32x4 (&acc)[2][2][4][2], const Unit& u, int wr, int wc, int fr, int fq) const {
        const int row0 = u.pm * BM + wr * 64 + fr; int colt = u.pn * BM; bf16_t* base = O;
        float sc = 1.f; if (split_cols) { const int t = colt / split_cols; base += (size_t)t * split_stride; colt -= t * split_cols; if (t == 0) sc = scale0; }
        const int col0 = colt + wc * 32 + 8 * fq, bcol0 = u.pn * BM + wc * 32 + 8 * fq;
        f32x4 bv[2][2];
#pragma unroll
        for (int bj = 0; bj < 2; ++bj)
#pragma unroll
            for (int n = 0; n < 2; ++n) bv[bj][n] = bias ? *(const f32x4*)(bias + bcol0 + bj * HALF + 4 * n) : (f32x4){0.f, 0.f, 0.f, 0.f};
#pragma unroll
        for (int ai = 0; ai < 2; ++ai)
#pragma unroll
            for (int m = 0; m < 4; ++m) { bf16_t* rowp = base + (size_t)(row0 + ai * HALF + m * 16) * ldc + col0;
#pragma unroll
                for (int bj = 0; bj < 2; ++bj) { f32x4 v0 = acc[ai][bj][m][0] + bv[bj][0], v1 = acc[ai][bj][m][1] + bv[bj][1];
                    if (ACT == 1) { f32x2 a = gelu_pk((f32x2){v0[0], v0[1]}), b = gelu_pk((f32x2){v0[2], v0[3]}), c = gelu_pk((f32x2){v1[0], v1[1]}), d = gelu_pk((f32x2){v1[2], v1[3]});
                        v0 = (f32x4){a.x, a.y, b.x, b.y}; v1 = (f32x4){c.x, c.y, d.x, d.y}; }
                    v0 = v0 * sc; v1 = v1 * sc; u32x4 w; w.x = cvt_pk_bf16(v0[0], v0[1]); w.y = cvt_pk_bf16(v0[2], v0[3]); w.z = cvt_pk_bf16(v1[0], v1[1]); w.w = cvt_pk_bf16(v1[2], v1[3]);
                    *(u32x4*)(rowp + bj * HALF) = w; } }
    }
};

template <class Epi, class Sched, bool ALIGN_EPI = false, bool SP2 = false, bool FP8 = false>
__device__ __forceinline__ void gemm_phase(PG8_LAS unsigned char* lds, const Gemm g, const Sched& S, const Epi& E) {
    const int tid = threadIdx.x, wid = __builtin_amdgcn_readfirstlane(tid >> 6), lane = tid & 63, wr = wid >> 2, wc = wid & 3, fr = lane & 15, fq = lane >> 4;
    const int K = g.K, nt = K / BK;
    unsigned voffA[2], voffB[2];
#pragma unroll
    for (int i = 0; i < 2; ++i) { int R, C; stage_rc(tid * 16 + i * 8192, R, C); const int Rb = Epi::PERM ? ((R & ~31) + perm32(R & 31)) : R;
        voffA[i] = (unsigned)(R * K + C) * 2u; voffB[i] = (unsigned)(Rb * K + C) * 2u; }
    const size_t kstep = (size_t)(BK * 2);
    const size_t hstep = (size_t)HALF * K * 2;
    const size_t tstep = 2 * hstep;
    const unsigned ldsw = (unsigned)wid * 1024u;
    const int aoff = lds_byte(wr * 64 + fr, fq * 8), boff = lds_byte(wc * 32 + fr, fq * 8);
#define PG8_SA(b, h) (((b) * 2 + (h)) * HTB)
#define PG8_SB(b, h) ((4 + (b) * 2 + (h)) * HTB)
#define PG8_STAGE(bufoff, gbase, voff) do { _Pragma("unroll") for (int _i = 0; _i < 2; ++_i) \
        __builtin_amdgcn_global_load_lds((const unsigned*)((const char*)(gbase) + (voff)[_i]), (PG8_LAS unsigned*)(lds + (bufoff) + ldsw + _i * 8192), 16, 0, 0); } while (0)
#define PG8_LDA(dst, b, h) do { if constexpr (FP8) { _Pragma("unroll") for (int m = 0; m < 4; ++m) { const pg8_v4i lo_ = *(const PG8_LAS pg8_v4i*)(lds + PG8_SA(b, h) + aoff + m * 2048), hi_ = *(const PG8_LAS pg8_v4i*)(lds + PG8_SA(b, h) + aoff + m * 2048 + 1024); \
            dst##8[m] = __builtin_shufflevector(lo_, hi_, 0, 1, 2, 3, 4, 5, 6, 7); } } \
        else { _Pragma("unroll") for (int m = 0; m < 4; ++m) _Pragma("unroll") for (int k = 0; k < 2; ++k) dst[m][k] = *(const PG8_LAS bf16x8*)(lds + PG8_SA(b, h) + aoff + m * 2048 + k * 1024); } } while (0)
#define PG8_LDB(dst, b, h) do { if constexpr (FP8) { _Pragma("unroll") for (int n = 0; n < 2; ++n) { const pg8_v4i lo_ = *(const PG8_LAS pg8_v4i*)(lds + PG8_SB(b, h) + boff + n * 2048), hi_ = *(const PG8_LAS pg8_v4i*)(lds + PG8_SB(b, h) + boff + n * 2048 + 1024); \
            dst##8[n] = __builtin_shufflevector(lo_, hi_, 0, 1, 2, 3, 4, 5, 6, 7); } } \
        else { _Pragma("unroll") for (int n = 0; n < 2; ++n) _Pragma("unroll") for (int k = 0; k < 2; ++k) dst[n][k] = *(const PG8_LAS bf16x8*)(lds + PG8_SB(b, h) + boff + n * 2048 + k * 1024); } } while (0)
#define PG8_MMA(ai, bj, At, Bt) do { __builtin_amdgcn_s_setprio(1); _Pragma("unroll") for (int m = 0; m < 4; ++m) _Pragma("unroll") for (int n = 0; n < 2; ++n) { \
        if constexpr (FP8) asm volatile("v_mfma_f32_16x16x128_f8f6f4 %0, %1, %2, %0" : "+v"(acc[ai][bj][m][n]) : "v"(Bt##8[n]), "v"(At##8[m]));     \
        else { _Pragma("unroll") for (int k = 0; k < 2; ++k) acc[ai][bj][m][n] = __builtin_amdgcn_mfma_f32_16x16x32_bf16(Bt[n][k], At[m][k], acc[ai][bj][m][n], 0, 0, 0); } } \
        __builtin_amdgcn_s_setprio(0); } while (0)
#define PG8_WAIT_V(n) asm volatile("s_waitcnt vmcnt(" #n ")" ::: "memory")
#define PG8_WAIT_L(n) asm volatile("s_waitcnt lgkmcnt(" #n ")" ::: "memory")
#define PG8_BAR __builtin_amdgcn_s_barrier()
#define PG8_SCHED __builtin_amdgcn_sched_barrier(0)
    Unit cur, nxt; int ui = 0;
    if (!S.next(0, cur)) return;
    f32x4 acc[2][2][4][2];
#pragma unroll
    for (int a = 0; a < 2; ++a)
#pragma unroll
        for (int b = 0; b < 2; ++b)
#pragma unroll
            for (int m = 0; m < 4; ++m)
#pragma unroll
                for (int n = 0; n < 2; ++n) acc[a][b][m][n] = (f32x4){0.f, 0.f, 0.f, 0.f};
    typedef int pg8_v4i __attribute__((ext_vector_type(4))); typedef int pg8_v8i __attribute__((ext_vector_type(8)));
    bf16x8 At[4][2], B0[2][2], B1[2][2]; pg8_v8i At8[4], B08[2], B18[2];
    const char* cA = (const char*)g.A + (size_t)cur.pm * tstep; const char* cB = (const char*)g.Bt + (size_t)cur.pn * tstep;
    S.a_ready(cur);
    if constexpr (SP2) {
        PG8_STAGE(PG8_SB(0, 0), cB, voffB); PG8_STAGE(PG8_SB(0, 1), cB + hstep, voffB); PG8_STAGE(PG8_SA(0, 0), cA, voffA); PG8_STAGE(PG8_SA(0, 1), cA + hstep, voffA);
        if (wr == 1) PG8_BAR;
        PG8_WAIT_V(2); PG8_BAR;
        PG8_STAGE(PG8_SB(1, 0), cB + kstep, voffB); PG8_STAGE(PG8_SA(1, 0), cA + kstep, voffA); PG8_STAGE(PG8_SB(1, 1), cB + hstep + kstep, voffB);
        PG8_WAIT_V(6); PG8_BAR;
    } else {
        PG8_STAGE(PG8_SB(0, 0), cB, voffB); PG8_STAGE(PG8_SA(0, 0), cA, voffA); PG8_STAGE(PG8_SB(0, 1), cB + hstep, voffB); PG8_STAGE(PG8_SA(0, 1), cA + hstep, voffA);
        if (wr == 1) PG8_BAR;
        PG8_WAIT_V(4); PG8_BAR;
        PG8_STAGE(PG8_SB(1, 0), cB + kstep, voffB); PG8_STAGE(PG8_SA(1, 0), cA + kstep, voffA); PG8_STAGE(PG8_SB(1, 1), cB + hstep + kstep, voffB);
        PG8_WAIT_V(6); PG8_BAR;
    }
    for (;;) {
        const bool has_next = S.next(ui + 1, nxt);
        const char* nA = has_next ? (const char*)g.A + (size_t)nxt.pm * tstep : cA; const char* nB = has_next ? (const char*)g.Bt + (size_t)nxt.pn * tstep : cB;
        for (int t = 0; t < nt; t += 2) {
            const bool last = (t == nt - 2);
            const char* a1 = cA + (size_t)(t + 1) * kstep;
            const char* a2 = last ? nA : cA + (size_t)(t + 2) * kstep; const char* b2 = last ? nB : cB + (size_t)(t + 2) * kstep;
            const char* a3 = a2 + kstep; const char* b3 = b2 + kstep;
            if (last && has_next) S.a_ready(nxt);
            if constexpr (SP2) {
            PG8_LDB(B0, 0, 0); PG8_LDB(B1, 0, 1); PG8_SCHED; PG8_LDA(At, 0, 0); PG8_STAGE(PG8_SA(1, 1), a1 + hstep, voffA);
            PG8_WAIT_V(8); PG8_WAIT_L(0); PG8_BAR; PG8_MMA(0, 0, At, B0); PG8_MMA(0, 1, At, B1); PG8_BAR; PG8_SCHED;
            PG8_LDA(At, 0, 1); PG8_STAGE(PG8_SB(0, 0), b2, voffB); PG8_STAGE(PG8_SB(0, 1), b2 + hstep, voffB); PG8_STAGE(PG8_SA(0, 0), a2, voffA);
            PG8_WAIT_V(8); PG8_WAIT_L(0); PG8_BAR; PG8_MMA(1, 0, At, B0); PG8_MMA(1, 1, At, B1); PG8_BAR; PG8_SCHED;
            PG8_LDB(B0, 1, 0); PG8_LDB(B1, 1, 1); PG8_SCHED; PG8_LDA(At, 1, 0); PG8_STAGE(PG8_SA(0, 1), a2 + hstep, voffA);
            PG8_WAIT_V(8); PG8_WAIT_L(0); PG8_BAR; PG8_MMA(0, 0, At, B0); PG8_MMA(0, 1, At, B1); PG8_BAR; PG8_SCHED;
            PG8_LDA(At, 1, 1); PG8_STAGE(PG8_SB(1, 0), b3, voffB); PG8_STAGE(PG8_SB(1, 1), b3 + hstep, voffB); PG8_STAGE(PG8_SA(1, 0), a3, voffA);
            PG8_WAIT_V(8); PG8_WAIT_L(0); PG8_BAR; PG8_MMA(1, 0, At, B0); PG8_MMA(1, 1, At, B1); PG8_BAR; PG8_SCHED;
            } else {
            PG8_LDB(B0, 0, 0); PG8_SCHED; PG8_LDA(At, 0, 0); PG8_STAGE(PG8_SA(1, 1), a1 + hstep, voffA);
            PG8_WAIT_L(8); PG8_BAR; PG8_WAIT_L(0); PG8_MMA(0, 0, At, B0); PG8_BAR; PG8_SCHED;
            PG8_LDB(B1, 0, 1); PG8_STAGE(PG8_SB(0, 0), b2, voffB);
            PG8_BAR; PG8_WAIT_L(0); PG8_MMA(0, 1, At, B1); PG8_BAR;
            PG8_LDA(At, 0, 1); PG8_STAGE(PG8_SA(0, 0), a2, voffA);
            PG8_BAR; PG8_WAIT_L(0); PG8_MMA(1, 0, At, B0); PG8_BAR; PG8_SCHED;
            PG8_STAGE(PG8_SB(0, 1), b2 + hstep, voffB);
            PG8_WAIT_V(6); PG8_BAR; PG8_MMA(1, 1, At, B1); PG8_BAR;
            PG8_LDB(B0, 1, 0); PG8_SCHED; PG8_LDA(At, 1, 0); PG8_STAGE(PG8_SA(0, 1), a2 + hstep, voffA);
            PG8_WAIT_L(8); PG8_BAR; PG8_WAIT_L(0); PG8_MMA(0, 0, At, B0); PG8_BAR; PG8_SCHED;
            PG8_LDB(B1, 1, 1); PG8_STAGE(PG8_SB(1, 0), b3, voffB);
            PG8_BAR; PG8_WAIT_L(0); PG8_MMA(0, 1, At, B1); PG8_BAR;
            PG8_LDA(At, 1, 1); PG8_STAGE(PG8_SA(1, 0), a3, voffA);
            PG8_BAR; PG8_WAIT_L(0); PG8_MMA(1, 0, At, B0); PG8_BAR; PG8_SCHED;
            PG8_STAGE(PG8_SB(1, 1), b3 + hstep, voffB);
            PG8_WAIT_V(6); PG8_BAR; PG8_MMA(1, 1, At, B1); PG8_BAR;
            }
        }
        if constexpr (ALIGN_EPI) { if (wr == 0) PG8_BAR; }
        if constexpr (FP8) asm volatile("s_nop 15\n\ts_nop 15\n\ts_nop 15" ::: "memory");
        if constexpr (!Epi::AFTER_DRAIN) {
            if constexpr (FP8) { const int l2_ = (int)__builtin_amdgcn_mbcnt_hi(~0u, __builtin_amdgcn_mbcnt_lo(~0u, 0u));
                E(acc, cur, wr, wc, l2_ & 15, l2_ >> 4); }
            else E(acc, cur, wr, wc, fr, fq);
            S.done(cur); }
        if (!has_next) break;
#pragma unroll
        for (int a = 0; a < 2; ++a)
#pragma unroll
            for (int b = 0; b < 2; ++b)
#pragma unroll
                for (int m = 0; m < 4; ++m)
#pragma unroll
                    for (int n = 0; n < 2; ++n) acc[a][b][m][n] = (f32x4){0.f, 0.f, 0.f, 0.f};
        cur = nxt; cA = nA; cB = nB; ++ui;
        if constexpr (ALIGN_EPI) { if (wr == 1) PG8_BAR; }
    }
    PG8_WAIT_V(0);
    if constexpr (!ALIGN_EPI) { if (wr == 0) PG8_BAR; }
    PG8_BAR;
    if constexpr (Epi::AFTER_DRAIN) { E.fused(acc, cur, wr, wc, fr, fq, lds, wid, lane); S.done(cur); }
#undef PG8_SA
#undef PG8_SB
#undef PG8_STAGE
#undef PG8_LDA
#undef PG8_LDB
#undef PG8_MMA
#undef PG8_WAIT_V
#undef PG8_WAIT_L
#undef PG8_BAR
#undef PG8_SCHED
}
}

constexpr int NWAVES = 8;
#ifndef MK_N_LAUNCHES
#define MK_N_LAUNCHES 1
#endif
constexpr int N_LAUNCHES = MK_N_LAUNCHES;
constexpr int PER_PHASE = 8;

constexpr int BATCH = 8, SEQ = 2048, DM = 2048, T = BATCH * SEQ;
constexpr int NH = 16, HD = 64;
constexpr int NGH = 4, GDK = 128, GDV = 256, GRANK = 16;
constexpr int DIN = 6160, NPROJ = 6144;
constexpr int C_AQ = 0, C_AK = 1024, C_AV = 2048, C_GQ = 3072, C_GK = 3584, C_GV = 4096, C_GR = 5120;
constexpr int PEH = 8, PEK = 128, PETOP = 16, NEXP = 16384;
constexpr float EPS = 1e-6f;
constexpr float LOG2E = 1.4426950408889634f;
constexpr float QSCALE = 0.125f * LOG2E;
constexpr float GQSCALE = 0.08838834764831845f;

constexpr size_t MiB = 1u << 20;
constexpr size_t WS_CTL = 0, CTL_ZERO_BYTES = 32 * 1024;
constexpr size_t WS_WIN = 1 * MiB;
constexpr size_t WS_WOUT = 26 * MiB;
constexpr size_t WS_WQ = 34 * MiB;
constexpr size_t WS_XN = 42 * MiB;
constexpr size_t WS_PROJ = 106 * MiB;
constexpr size_t WS_U = 298 * MiB;
constexpr size_t WS_V = 330 * MiB;
constexpr size_t WS_SC = 362 * MiB;
constexpr size_t WS_MIX = 363 * MiB;
constexpr size_t WS_GA = 427 * MiB;
constexpr size_t WS_IDX = 428 * MiB;
constexpr size_t WS_GATE = 436 * MiB;
constexpr size_t WS_LB = 444 * MiB;
constexpr size_t WS_HN = 445 * MiB;
constexpr size_t WS_SSQ = 509 * MiB;
constexpr size_t WS_RSTD = 362 * MiB + 512 * 1024;
constexpr size_t WS_XQ8 = WS_PROJ + 64 * MiB;
constexpr size_t WS_XN8 = WS_HN;
constexpr size_t WS_WIN8 = WS_HN + 32 * MiB;
constexpr float WIN8_SCALE = 128.f;
constexpr size_t WS_MIX8 = WS_MIX;
constexpr size_t WS_WOUT8 = WS_WOUT;
constexpr size_t WS_WQ8 = WS_WQ;
constexpr size_t WS_H18 = WS_MIX + 32 * MiB;
constexpr float H18_SCALE = 8.f;
constexpr float MIX8_SCALE = 16.f;
constexpr int F8_A0 = 0, F8_A1 = 3072, F8_B0 = 4096, F8_B1 = 6144;
__host__ __device__ constexpr bool is_f8_col(int n) { return (n >= F8_A0 && n < F8_A1) || (n >= F8_B0 && n < F8_B1); }
constexpr size_t WS_RMS1 = 362 * MiB + 640 * 1024;
constexpr size_t WS_END = 511 * MiB;
constexpr int CW_TMO = 0, CW_CODE = 1, CW_ATTQ = 64, CW_BAR = 4096;

constexpr int RING_OFF = 0, RING_BYTES = 131072;
constexpr int LDS_BYTES = 147456;
constexpr int LDSCTL_OFF = LDS_BYTES - 512, MISC_OFF = LDSCTL_OFF + 320;

#define GAS __attribute__((address_space(1)))
#define LAS __attribute__((address_space(3)))
typedef unsigned short bf16;
typedef unsigned v4u __attribute__((ext_vector_type(4)));
typedef unsigned v2u __attribute__((ext_vector_type(2)));
typedef float f32x4 __attribute__((ext_vector_type(4)));
typedef short bf16x8 __attribute__((ext_vector_type(8)));
typedef GAS unsigned gu32;
#define RLX_AGENT __ATOMIC_RELAXED, __HIP_MEMORY_SCOPE_AGENT
#define LDS_WAIT() asm volatile("s_waitcnt lgkmcnt(0)" ::: "memory")
#define VM_WAIT() asm volatile("s_waitcnt vmcnt(0)" ::: "memory")
__device__ __forceinline__ unsigned f2bf(float f) { unsigned u = __builtin_bit_cast(unsigned, f); return (u + 0x7fffu + ((u >> 16) & 1u)) >> 16; }
__device__ __forceinline__ unsigned pk2(float lo, float hi) { return f2bf(lo) | (f2bf(hi) << 16); }
__device__ __forceinline__ float bf2f(unsigned short b) { return __builtin_bit_cast(float, (unsigned)b << 16); }
__device__ __forceinline__ float bflo(unsigned w) { return __builtin_bit_cast(float, w << 16); }
__device__ __forceinline__ float bfhi(unsigned w) { return __builtin_bit_cast(float, w & 0xffff0000u); }
__device__ __forceinline__ unsigned bf4_to_f8(unsigned lo, unsigned hi) {
    int w = 0; w = __builtin_amdgcn_cvt_pk_fp8_f32(bflo(lo) * MIX8_SCALE, bfhi(lo) * MIX8_SCALE, w, false); w = __builtin_amdgcn_cvt_pk_fp8_f32(bflo(hi) * MIX8_SCALE, bfhi(hi) * MIX8_SCALE, w, true); return (unsigned)w; }

#define XB_TMO      128
#define XB_XCNT(j)  (256  + 64 * (j))
#define XB_XSUB(j)  (1280 + 64 * (j))
#define XB_XGEN(j)  (2304 + 64 * (j))
#define XB_TOP      3328
#define XB_TOPGEN   3392
#define XCD_BAR_WORDS 3456
#define XB_SPIN_CAP (1u << 22)

__device__ __forceinline__ unsigned xb_ld(unsigned* p)              { return __hip_atomic_load(p, __ATOMIC_RELAXED, __HIP_MEMORY_SCOPE_AGENT); }
__device__ __forceinline__ unsigned xb_add(unsigned* p, unsigned v) { return __hip_atomic_fetch_add(p, v, __ATOMIC_RELAXED, __HIP_MEMORY_SCOPE_AGENT); }
__device__ __forceinline__ unsigned xb_xcc_id() { return (unsigned)__builtin_amdgcn_s_getreg((3 << 11) | 20) & 0xFu; }
#define XB_SPIN(cond, bar) do { unsigned _sp = 0; while (cond) { __builtin_amdgcn_s_sleep(1); \
    if ((++_sp & 255u) == 0u) { if (xb_ld(&(bar)[XB_TMO])) break; if (_sp > XB_SPIN_CAP) { atomicAdd(&(bar)[XB_TMO], 1u); break; } } } } while (0)

struct XcdBarrier { unsigned* bar; unsigned x; volatile LAS unsigned* st; };

__device__ __forceinline__ XcdBarrier xcd_barrier_post(unsigned* bar, volatile LAS unsigned* st) {
    XcdBarrier b; b.bar = bar; b.x = xb_xcc_id(); b.st = st;
    if (threadIdx.x == 0) (void)xb_add(&bar[XB_XCNT(b.x)], 1u);
    return b;
}
__device__ __forceinline__ void xcd_barrier_complete(unsigned* bar, unsigned x, unsigned& nloc, unsigned& nx) {
    const unsigned G = gridDim.x * gridDim.y * gridDim.z;
    unsigned sum, cnt, mine, sp = 0u;
    for (;;) {
        sum = 0u; cnt = 0u; mine = 0u;
#pragma unroll
        for (unsigned j = 0; j < 16; ++j) { const unsigned c = xb_ld(&bar[XB_XCNT(j)]); sum += c; cnt += (c > 0u) ? 1u : 0u; mine = (j == x) ? c : mine; }
        if (sum == G) break;
        __builtin_amdgcn_s_sleep(1);
        if ((++sp & 255u) == 0u) { if (xb_ld(&bar[XB_TMO])) break; if (sp > XB_SPIN_CAP) { atomicAdd(&bar[XB_TMO], 1u); break; } }
    }
    nloc = mine > 0u ? mine : 1u; nx = cnt > 0u ? cnt : 1u;
}
__device__ __forceinline__ void xcd_barrier(const XcdBarrier& b) {
    asm volatile("s_waitcnt vmcnt(0)" ::: "memory");
    __syncthreads();
    if (threadIdx.x == 0) {
        unsigned* bar = b.bar;
        __builtin_amdgcn_s_waitcnt(0);
        unsigned nloc = b.st[0], nx = b.st[1];
        if (nloc == 0u) { xcd_barrier_complete(bar, b.x, nloc, nx); b.st[0] = nloc; b.st[1] = nx; }
        const unsigned old = xb_add(&bar[XB_XSUB(b.x)], 1u);
        const unsigned gen = old / nloc;
        if (old + 1u == (gen + 1u) * nloc) {
            __builtin_amdgcn_fence(__ATOMIC_RELEASE, "agent");
            asm volatile("s_waitcnt vmcnt(0)" ::: "memory");
            const unsigned og = xb_add(&bar[XB_TOP], 1u);
            const unsigned tg = og / nx;
            if (og + 1u == (tg + 1u) * nx) xb_add(&bar[XB_TOPGEN], 1u);
            else XB_SPIN(xb_ld(&bar[XB_TOPGEN]) == tg, bar);
            __builtin_amdgcn_fence(__ATOMIC_ACQUIRE, "agent"); asm volatile("buffer_inv sc0 sc1" ::: "memory");
            xb_add(&bar[XB_XGEN(b.x)], 1u);
            asm volatile("s_waitcnt vmcnt(0)" ::: "memory");
        } else {
            XB_SPIN(xb_ld(&bar[XB_XGEN(b.x)]) == gen, bar);
            __builtin_amdgcn_fence(__ATOMIC_ACQUIRE, "agent"); asm volatile("buffer_inv sc0 sc1" ::: "memory");
            asm volatile("s_waitcnt vmcnt(0)" ::: "memory");
        }
    }
    __syncthreads();
}

namespace pg8 {
struct EpiProj {
    static constexpr bool PERM = true, AFTER_DRAIN = false;
    bf16_t* O; int ldc; float osc; int pn0;
    __device__ __forceinline__ void operator()(const f32x4 (&acc)[2][2][4][2], const Unit& u, int wr, int wc, int fr, int fq) const {
        const int row0 = u.pm * BM + wr * 64 + fr; const int col0 = (u.pn + pn0) * BM + wc * 32 + 8 * fq;
        const float sc = ((u.pn + pn0 < 4) ? QSCALE : 1.f) * osc;
#pragma unroll
        for (int ai = 0; ai < 2; ++ai)
#pragma unroll
            for (int m = 0; m < 4; ++m) { bf16_t* rowp = O + (size_t)(row0 + ai * HALF + m * 16) * ldc + col0;
#pragma unroll
                for (int bj = 0; bj < 2; ++bj) { f32x4 v0 = acc[ai][bj][m][0] * sc, v1 = acc[ai][bj][m][1] * sc;
                    u32x4 w; w.x = cvt_pk_bf16(v0[0], v0[1]); w.y = cvt_pk_bf16(v0[2], v0[3]); w.z = cvt_pk_bf16(v1[0], v1[1]); w.w = cvt_pk_bf16(v1[2], v1[3]);
                    *(u32x4*)(rowp + bj * HALF) = w; } }
    }
};
struct EpiRes {
    static constexpr bool PERM = false, AFTER_DRAIN = false;
    const float* base; float* C; int ldc;
    __device__ __forceinline__ void operator()(const f32x4 (&acc)[2][2][4][2], const Unit& u, int wr, int wc, int fr, int fq) const {
        const int row0 = u.pm * BM + wr * 64 + fr, col0 = u.pn * BM + wc * 32 + 4 * fq;
#pragma unroll
        for (int ai = 0; ai < 2; ++ai)
#pragma unroll
            for (int m = 0; m < 4; ++m) { const size_t off = (size_t)(row0 + ai * HALF + m * 16) * ldc + col0;
#pragma unroll
                for (int bj = 0; bj < 2; ++bj)
#pragma unroll
                    for (int n = 0; n < 2; ++n) *(f32x4*)(C + off + bj * HALF + n * 16) = acc[ai][bj][m][n] + *(const f32x4*)(base + off + bj * HALF + n * 16); }
    }
};
struct EpiRes2 {
    static constexpr bool PERM = true, AFTER_DRAIN = false;
    const bf16_t* XNb; const float* RMS1; const float* G1; bf16_t* CB; float* SSQ; int ldc; int M;
    __device__ __forceinline__ void operator()(const f32x4 (&acc)[2][2][4][2], const Unit& u, int wr, int wc, int fr, int fq) const {
        const int row0 = u.pm * BM + wr * 64 + fr, col0 = u.pn * BM + wc * 32 + 8 * fq;
        float* sq = SSQ + (size_t)(u.pn * 4 + wc) * M;
        constexpr float osc = 1.f / (WIN8_SCALE * MIX8_SCALE);
        unsigned char* C8 = (unsigned char*)CB + ((long long)WS_H18 - (long long)WS_HN);
        f32x4 ig[2][2];
#pragma unroll
        for (int bj = 0; bj < 2; ++bj)
#pragma unroll
            for (int n = 0; n < 2; ++n) { const f32x4 g = *(const f32x4*)(G1 + col0 + bj * HALF + 4 * n); ig[bj][n] = (f32x4){1.f / g[0], 1.f / g[1], 1.f / g[2], 1.f / g[3]}; }
#pragma unroll
        for (int ai = 0; ai < 2; ++ai) { constexpr int m0 = 0;
            u32x4 xb[4][2]; float rm[4];
#pragma unroll
            for (int m = 0; m < 4; ++m)
#pragma unroll
                for (int bj = 0; bj < 2; ++bj) xb[m][bj] = *(const u32x4*)(XNb + (size_t)(row0 + ai * HALF + (m + m0) * 16) * ldc + col0 + bj * HALF);
#pragma unroll
            for (int m = 0; m < 4; ++m) rm[m] = RMS1[row0 + ai * HALF + (m + m0) * 16];
#pragma unroll
            for (int m = 0; m < 4; ++m) { const int row = row0 + ai * HALF + (m + m0) * 16; const size_t off = (size_t)row * ldc + col0; float ss = 0.f;
#pragma unroll
                for (int bj = 0; bj < 2; ++bj) { const u32x4 xw = xb[m][bj];
                    const f32x4 x0 = (f32x4){bflo(xw.x), bfhi(xw.x), bflo(xw.y), bfhi(xw.y)} * rm[m] * ig[bj][0], x1 = (f32x4){bflo(xw.z), bfhi(xw.z), bflo(xw.w), bfhi(xw.w)} * rm[m] * ig[bj][1];
                    const f32x4 v0 = acc[ai][bj][m + m0][0] * osc + x0, v1 = acc[ai][bj][m + m0][1] * osc + x1;
                    u32x4 w; w.x = cvt_pk_bf16(v0[0], v0[1]); w.y = cvt_pk_bf16(v0[2], v0[3]); w.z = cvt_pk_bf16(v1[0], v1[1]); w.w = cvt_pk_bf16(v1[2], v1[3]);
                    *(u32x4*)(CB + off + bj * HALF) = w;
                    { int e0 = 0, e1 = 0; e0 = __builtin_amdgcn_cvt_pk_fp8_f32(v0[0] * 8.f, v0[1] * 8.f, e0, false); e0 = __builtin_amdgcn_cvt_pk_fp8_f32(v0[2] * 8.f, v0[3] * 8.f, e0, true);
                      e1 = __builtin_amdgcn_cvt_pk_fp8_f32(v1[0] * 8.f, v1[1] * 8.f, e1, false); e1 = __builtin_amdgcn_cvt_pk_fp8_f32(v1[2] * 8.f, v1[3] * 8.f, e1, true);
                      typedef unsigned u32x2_ __attribute__((ext_vector_type(2))); *(u32x2_*)(C8 + off + bj * HALF) = (u32x2_){(unsigned)e0, (unsigned)e1}; }
                    ss += (v0[0] * v0[0] + v0[1] * v0[1]) + (v0[2] * v0[2] + v0[3] * v0[3]) + (v1[0] * v1[0] + v1[1] * v1[1]) + (v1[2] * v1[2] + v1[3] * v1[3]); }
                ss += __shfl_xor(ss, 16); ss += __shfl_xor(ss, 32);
                if (fq == 0) sq[row] = ss; }
        }
    }
};
}

struct Frame {
    LAS unsigned char* lds;
    volatile LAS unsigned* MISC;
    gu32* ctl;
    int tid, lane, wave;
    int vcu, G;
    const float *x, *ln1g, *w_in, *rel_bias, *wg2, *bgate, *gng, *w_out, *ln2g, *w_q, *keys1, *keys2, *pu, *pv, *lnfg;
    float* out;
    bf16 *WinT, *WoutT, *WqT, *XN, *MIX, *HN, *PROJ, *PQ; unsigned char *U8, *V8;
    float *GA, *GATE, *LB, *SC, *SSQ, *RSTD, *RMS1; unsigned char *XQ8, *XN8, *WIN8, *MIX8, *WOUT8, *WQ8, *H18; int* IDX;
};

__device__ __forceinline__ float wave_sum(float v) {
#pragma unroll
    for (int o = 1; o < 64; o <<= 1) v += __shfl_xor(v, o);
    return v;
}
__device__ __forceinline__ float wave_max(float v) {
#pragma unroll
    for (int o = 1; o < 64; o <<= 1) v = fmaxf(v, __shfl_xor(v, o));
    return v;
}

__device__ __forceinline__ unsigned q8pack(float a, float b_, float c, float d) {
    const int qa = (int)__builtin_rintf(a), qb = (int)__builtin_rintf(b_), qc = (int)__builtin_rintf(c), qd = (int)__builtin_rintf(d);
    return ((unsigned)qa & 255u) | (((unsigned)qb & 255u) << 8) | (((unsigned)qc & 255u) << 16) | ((unsigned)qd << 24);
}
__device__ __forceinline__ void transpose_item(const float* W, int K, int N, bf16* WT, int src_n0, int dst_n0, int ncols, int k0, LAS float* scr, int lane, const float* gk = nullptr, unsigned char* WT8 = nullptr) {
    const int ch = lane & 7, kr = lane >> 3; const bool ok = 4 * ch < ncols;
#pragma unroll
    for (int i = 0; i < 8; ++i) { const int kk = 8 * i + kr; f32x4 v = {0.f, 0.f, 0.f, 0.f};
        if (ok) v = *(const GAS f32x4*)(W + (size_t)(k0 + kk) * N + src_n0 + 4 * ch);
        LAS float* d = scr + kk * 33 + 4 * ch; d[0] = v.x; d[1] = v.y; d[2] = v.z; d[3] = v.w; }
    LDS_WAIT(); asm volatile("" ::: "memory");
    const int c = lane & 7;
    f32x4 g0 = {1.f, 1.f, 1.f, 1.f}, g1 = g0;
    if (gk) { g0 = *(const GAS f32x4*)(gk + k0 + 8 * c); g1 = *(const GAS f32x4*)(gk + k0 + 8 * c + 4); }
#pragma unroll
    for (int j = 0; j < 4; ++j) { const int n = (lane >> 3) + 8 * j; const LAS float* s = scr + (8 * c) * 33 + n;
        v4u o; o.x = pk2(s[0 * 33] * g0.x, s[1 * 33] * g0.y); o.y = pk2(s[2 * 33] * g0.z, s[3 * 33] * g0.w); o.z = pk2(s[4 * 33] * g1.x, s[5 * 33] * g1.y); o.w = pk2(s[6 * 33] * g1.z, s[7 * 33] * g1.w);
        if (WT8) { int w0 = 0, w1 = 0;
            w0 = __builtin_amdgcn_cvt_pk_fp8_f32(s[0 * 33] * g0.x * WIN8_SCALE, s[1 * 33] * g0.y * WIN8_SCALE, w0, false); w0 = __builtin_amdgcn_cvt_pk_fp8_f32(s[2 * 33] * g0.z * WIN8_SCALE, s[3 * 33] * g0.w * WIN8_SCALE, w0, true);
            w1 = __builtin_amdgcn_cvt_pk_fp8_f32(s[4 * 33] * g1.x * WIN8_SCALE, s[5 * 33] * g1.y * WIN8_SCALE, w1, false); w1 = __builtin_amdgcn_cvt_pk_fp8_f32(s[6 * 33] * g1.z * WIN8_SCALE, s[7 * 33] * g1.w * WIN8_SCALE, w1, true);
            if (n < ncols) *(GAS v2u*)(WT8 + (size_t)(dst_n0 + n) * K + k0 + 8 * c) = (v2u){(unsigned)w0, (unsigned)w1}; }
        else if (n < ncols) *(GAS v4u*)(WT + (size_t)(dst_n0 + n) * K + k0 + 8 * c) = o; }
    LDS_WAIT(); asm volatile("" ::: "memory");
}
__device__ __forceinline__ void rms_row_to_bf16(const float* xrow, const f32x4 (&gv)[8], bf16* orow, int lane, float* rms_out, unsigned char* orow8) {
    const GAS f32x4* xr = (const GAS f32x4*)xrow + lane;
    f32x4 v[8]; float s = 0.f;
#pragma unroll
    for (int j = 0; j < 8; ++j) { v[j] = xr[64 * j]; s += (v[j].x * v[j].x + v[j].y * v[j].y) + (v[j].z * v[j].z + v[j].w * v[j].w); }
    const float rstd = rsqrtf(wave_sum(s) * (1.f / DM) + EPS);
    if (lane == 0) *rms_out = 1.f / rstd;
    GAS v2u* o8 = (GAS v2u*)orow + lane;
#pragma unroll
    for (int j = 0; j < 8; ++j) { const f32x4 gg = gv[j];
        const float y0 = v[j].x * rstd * gg.x, y1 = v[j].y * rstd * gg.y, y2 = v[j].z * rstd * gg.z, y3 = v[j].w * rstd * gg.w;
        v2u o; o.x = pk2(y0, y1); o.y = pk2(y2, y3); o8[64 * j] = o;
        int w8 = 0; w8 = __builtin_amdgcn_cvt_pk_fp8_f32(y0, y1, w8, false); w8 = __builtin_amdgcn_cvt_pk_fp8_f32(y2, y3, w8, true);
        *(GAS unsigned*)(orow8 + 256 * j + 4 * lane) = (unsigned)w8; }
}

__device__ __forceinline__ void p0_prologue(Frame& F) {
    LAS float* scr = (LAS float*)(F.lds + RING_OFF + F.wave * 16384);
    const int gw = F.vcu * NWAVES + F.wave, NGW = F.G * NWAVES;
    const int gtid = F.vcu * (NWAVES * 64) + F.tid, NT = F.G * NWAVES * 64;
    constexpr int KB = DM / 64;
    constexpr int NB_IN = 160 + 32 + 1;
    constexpr int I_IN = KB * NB_IN, I_O = KB * (DM / 32), I_Q = KB * (DM / 32);
    for (int it = gw; it < I_IN + I_O + I_Q; it += NGW) {
        int r = it;
        if (r < I_IN) { const int kb = r / NB_IN, nb = r % NB_IN; int s0, d0, nc = 32;
            if (nb < 160) { s0 = 32 * nb; d0 = s0; } else if (nb < 192) { s0 = 5136 + 32 * (nb - 160); d0 = 5120 + 32 * (nb - 160); } else { s0 = 5120; d0 = 6144; nc = 16; }
            transpose_item(F.w_in, DM, DIN, F.WinT, s0, d0, nc, 64 * kb, scr, F.lane, nullptr, (nb < 192 && is_f8_col(d0)) ? F.WIN8 : nullptr); continue; }
        r -= I_IN;
        if (r < I_O) { const int kb = r / (DM / 32), nb = r % (DM / 32); transpose_item(F.w_out, DM, DM, F.WoutT, 32 * nb, 32 * nb, 32, 64 * kb, scr, F.lane, nullptr, F.WOUT8); continue; }
        r -= I_O;
        { const int kb = r / (DM / 32), nb = r % (DM / 32); transpose_item(F.w_q, DM, DM, F.WqT, 32 * nb, 32 * nb, 32, 64 * kb, scr, F.lane, F.ln2g, F.WQ8); }
    }
    f32x4 g2v[8];
#pragma unroll
    for (int j = 0; j < 8; ++j) g2v[j] = ((const GAS f32x4*)F.ln2g)[64 * j + F.lane];
    for (int row = gw; row < 2 * NEXP; row += NGW) {
        const bool isv = row >= NEXP; const int e = isv ? row - NEXP : row;
        const GAS f32x4* src = (const GAS f32x4*)((isv ? F.pv : F.pu) + (size_t)e * DM) + F.lane;
        f32x4 v[8]; float am = 0.f;
#pragma unroll
        for (int j = 0; j < 8; ++j) v[j] = src[64 * j];
#pragma unroll
        for (int j = 0; j < 8; ++j) { f32x4 t = v[j]; if (!isv) t = t * g2v[j];
            v[j] = t; am = fmaxf(am, fmaxf(fmaxf(fabsf(t.x), fabsf(t.y)), fmaxf(fabsf(t.z), fabsf(t.w)))); }
        am = wave_max(am);
        const float sc = fmaxf(am, 1e-30f) * (isv ? (1.f / 448.f) : (1.f / 127.f)), inv = 1.f / sc;
        unsigned char* tb = isv ? F.V8 : F.U8;
#pragma unroll
        for (int j = 0; j < 8; ++j) { const f32x4 t = v[j] * inv; int w = 0;
            if (isv) { w = __builtin_amdgcn_cvt_pk_fp8_f32(t.x, t.y, w, false); w = __builtin_amdgcn_cvt_pk_fp8_f32(t.z, t.w, w, true); }
            else w = (int)q8pack(t.x, t.y, t.z, t.w);
            *(GAS unsigned*)(tb + ((size_t)(2 * j + (F.lane >> 5)) * NEXP + e) * 128 + 4 * (F.lane & 31)) = (unsigned)w; }
        if (F.lane == 0) F.SC[row] = sc;
    }
    { f32x4 g1v[8];
#pragma unroll
      for (int j = 0; j < 8; ++j) g1v[j] = ((const GAS f32x4*)F.ln1g)[64 * j + F.lane];
      for (int m = gw; m < T; m += NGW) rms_row_to_bf16(F.x + (size_t)m * DM, g1v, F.XN + (size_t)m * DM, F.lane, F.RMS1 + m, F.XN8 + (size_t)m * DM); }
    for (int i = gtid; i < NH * SEQ; i += NT) {
        const int h = i >> 11, dist = i & 2047;
        const int cnt = (dist <= 128 ? 1 : 0) + (((dist & 3) == 0 && dist <= 512) ? 1 : 0) + (((dist & 15) == 0) ? 1 : 0);
        int bucket = dist;
        if (dist >= 16) { bucket = 16 + (int)(log((double)dist / 16.0) / log(128.0) * 16.0); if (bucket > 31) bucket = 31; }
        F.LB[i] = cnt ? F.rel_bias[bucket * NH + h] * LOG2E + log2f((float)cnt) : -1e30f;
    }
}

__device__ __forceinline__ void ga_mfma(Frame& F) {
    typedef float f32x4_t __attribute__((ext_vector_type(4)));
    const int gw = F.vcu * NWAVES + F.wave, NGW = F.G * NWAVES, lane = F.lane, r16 = lane & 15, kg = lane >> 4;
    for (int task = gw; task < T / 16; task += NGW) {
        const bf16* ap = F.XN + (size_t)(task * 16 + r16) * DM + 8 * kg;
        const bf16* bp = F.WinT + (size_t)(NPROJ + r16) * DM + 8 * kg;
        f32x4_t acc = {0.f, 0.f, 0.f, 0.f};
#pragma unroll 8
        for (int ks = 0; ks < DM / 32; ++ks) { const bf16x8 a = *(const GAS bf16x8*)(ap + 32 * ks), bb = *(const GAS bf16x8*)(bp + 32 * ks);
            acc = __builtin_amdgcn_mfma_f32_16x16x32_bf16(a, bb, acc, 0, 0, 0); }
#pragma unroll
        for (int r = 0; r < 4; ++r) F.GA[(size_t)(task * 16 + 4 * kg + r) * 16 + r16] = acc[r];
    }
}

namespace att {
typedef short s16x4 __attribute__((ext_vector_type(4)));
typedef short v4i16_t __attribute__((ext_vector_type(4)));
typedef float f32x16 __attribute__((ext_vector_type(16)));
typedef float f32x2_t __attribute__((ext_vector_type(2))); typedef __bf16 bf16x2_t __attribute__((ext_vector_type(2)));
__device__ __forceinline__ unsigned cvtpk(float lo, float hi) { f32x2_t v = {lo, hi}; bf16x2_t bb = __builtin_convertvector(v, bf16x2_t); return __builtin_bit_cast(unsigned, bb); }
__device__ __forceinline__ s16x4 vtr(const LAS unsigned char* p) { return __builtin_bit_cast(s16x4, __builtin_amdgcn_ds_read_tr16_b64_v4i16((LAS v4i16_t*)p)); }
__device__ __forceinline__ int crow(int r, int hi) { return (r & 3) + 8 * (r >> 2) + 4 * hi; }
constexpr int KST = 144, TILEB = 64 * KST;
constexpr int L_LB = 0, L_K = 9856, L_V = L_K + 2 * TILEB, L_WS = L_V + 2 * TILEB;
constexpr int N_UNITS = BATCH * NH * (SEQ / 256);
#define ATT_MFMA(a, b, c) __builtin_amdgcn_mfma_f32_32x32x16_bf16((a), (b), (c), 0, 0, 0)

__device__ __forceinline__ void attn_unit(Frame& F, int b, int hh, int qb) {
    LAS unsigned char* lds = F.lds;
    const int tid = F.tid, lane = F.lane, w = F.wave, r32 = lane & 31, hi = lane >> 5;
    const int q0 = qb * 256, NT = (q0 + 256) >> 6, nfar = qb > 2 ? qb - 2 : 0, kt0 = 4 * nfar;
    const int qposl = q0 + 2 * w + (r32 >> 4) + 16 * (r32 & 15);
    const size_t rowb = (size_t)b * SEQ;
    LAS float* LBs = (LAS float*)(lds + L_LB);
    __syncthreads();
    float lbv[5];
#pragma unroll
    for (int j = 0; j < 5; ++j) { const int i = tid + 512 * j; lbv[j] = (i >= 256 && i < 2304) ? F.LB[hh * SEQ + i - 256] : -1e30f; }
    bf16x8 qr[4];
    { const bf16* qp = F.PROJ + (rowb + qposl) * NPROJ + C_AQ + hh * 64 + hi * 8;
#pragma unroll
      for (int ks = 0; ks < 4; ++ks) qr[ks] = *(const GAS bf16x8*)(qp + 16 * ks); }
    const int srow = tid >> 3, sch = tid & 7;
    const bf16* kg = F.PROJ + (rowb + srow) * NPROJ + C_AK + hh * 64 + sch * 8;
    const bf16* vg = F.PROJ + (rowb + srow) * NPROJ + C_AV + hh * 64 + sch * 8;
    const int soff = srow * KST + sch * 16;
    v4u kreg = *(const GAS v4u*)(kg + (size_t)kt0 * 64 * NPROJ), vreg = *(const GAS v4u*)(vg + (size_t)kt0 * 64 * NPROJ);
    *(LAS v4u*)(lds + L_K + soff) = kreg; *(LAS v4u*)(lds + L_V + soff) = vreg;
#pragma unroll
    for (int j = 0; j < 5; ++j) { const int i = tid + 512 * j; if (i < 2304) LBs[i + (i >> 4)] = lbv[j]; }
    kreg = *(const GAS v4u*)(kg + (size_t)(kt0 + 1) * 64 * NPROJ); vreg = *(const GAS v4u*)(vg + (size_t)(kt0 + 1) * 64 * NPROJ);
    f32x16 o0, o1;
#pragma unroll
    for (int r = 0; r < 16; ++r) { o0[r] = 0.f; o1[r] = 0.f; }
    float mref = 0.f, l = 0.f;
    bool first = true;
    const int B0 = 256 + qposl - 4 * hi, nib = B0 & 15, Sd0 = B0 + (B0 >> 4);
    int bwm = 0;
#pragma unroll
    for (int mi = 0; mi < 8; ++mi) bwm |= ((nib < ((mi & 3) + 8 * (mi >> 2))) ? 1 : 0) << mi;
    const int bwf = (r32 >> 4) == 0 ? 1 : 0;
    LAS float* wsf = (LAS float*)(lds + L_WS + w * 256);
    LAS unsigned char* fv = lds + L_WS + 2048 + w * 4608;
    const int q4 = (lane & 15) >> 2, p4 = lane & 3, blk = (lane >> 4) & 1;
    const int voff = (4 * hi + q4) * KST + (16 * blk + 4 * p4) * 2;
    const int koff = r32 * KST + hi * 16;
    __syncthreads();
#pragma unroll 1
    for (int st = 0; st < nfar; ++st) {
        const int kb = 256 * st;
        bf16x8 ka[4]; v4u vv[4];
        { const bf16* kp = F.PROJ + (rowb + kb + 2 * w + (r32 >> 4) + 16 * (r32 & 15)) * NPROJ + C_AK + hh * 64 + hi * 8;
#pragma unroll
          for (int ks = 0; ks < 4; ++ks) ka[ks] = *(const GAS bf16x8*)(kp + 16 * ks);
          const int vr = lane >> 1, vh = lane & 1;
          const bf16* vpg = F.PROJ + (rowb + kb + 2 * w + (vr >> 4) + 16 * (vr & 15)) * NPROJ + C_AV + hh * 64 + 32 * vh;
#pragma unroll
          for (int i = 0; i < 4; ++i) vv[i] = *(const GAS v4u*)(vpg + 8 * i);
#pragma unroll
          for (int i = 0; i < 4; ++i) *(LAS v4u*)(fv + vr * KST + 64 * vh + 16 * i) = vv[i]; }
        f32x16 s0; const float ninit = -mref;
#pragma unroll
        for (int r = 0; r < 16; ++r) s0[r] = ninit;
#pragma unroll
        for (int ks = 0; ks < 4; ++ks) s0 = ATT_MFMA(ka[ks], qr[ks], s0);
        const int Bf = 256 + qposl - kb - 2 * w - 64 * hi; const LAS float* lbf = LBs + (Bf + (Bf >> 4));
        float tm = -3.0e38f;
        float bvf[16];
#pragma unroll
        for (int r = 0; r < 16; ++r) { const int off = (r >> 3) + 16 * (r & 3) + 128 * ((r >> 2) & 1); bvf[r] = lbf[-(off + (off >> 4)) - ((r >> 3) ? bwf : 0)]; }
        LDS_WAIT(); asm volatile("" ::: "memory");
#pragma unroll
        for (int r = 0; r < 16; ++r) { asm volatile("" : "+v"(bvf[r])); s0[r] += bvf[r]; tm = fmaxf(tm, s0[r]); }
        tm = fmaxf(tm, __shfl_xor(tm, 32));
        if (first || __any(tm > 8.f)) {
            const float d = first ? tm : fmaxf(tm, 0.f);
            mref += d; const float f = __builtin_amdgcn_exp2f(-d); l *= f;
#pragma unroll
            for (int r = 0; r < 16; ++r) s0[r] -= d;
            if (!first) {
                if (hi == 0) wsf[r32] = f;
                LDS_WAIT(); asm volatile("" ::: "memory");
#pragma unroll
                for (int r = 0; r < 16; ++r) { const float fr = wsf[crow(r, hi)]; o0[r] *= fr; o1[r] *= fr; }
                LDS_WAIT(); asm volatile("" ::: "memory");
            }
            first = false;
        }
        float ps = 0.f;
#pragma unroll
        for (int r = 0; r < 16; ++r) { s0[r] = __builtin_amdgcn_exp2f(s0[r]); ps += s0[r]; }
        l += ps;
        LDS_WAIT(); asm volatile("" ::: "memory");
#pragma unroll
        for (int s = 0; s < 2; ++s) {
            v4u pw; pw.x = cvtpk(s0[8 * s], s0[8 * s + 1]); pw.y = cvtpk(s0[8 * s + 2], s0[8 * s + 3]); pw.z = cvtpk(s0[8 * s + 4], s0[8 * s + 5]); pw.w = cvtpk(s0[8 * s + 6], s0[8 * s + 7]);
            const bf16x8 pa = __builtin_bit_cast(bf16x8, pw);
            const LAS unsigned char* vp = fv + voff + (16 * s) * KST;
            { const s16x4 lo = vtr(vp), hh2 = vtr(vp + 8 * KST); const bf16x8 vb = __builtin_shufflevector(lo, hh2, 0, 1, 2, 3, 4, 5, 6, 7); o0 = ATT_MFMA(pa, vb, o0); }
            { const s16x4 lo = vtr(vp + 64), hh2 = vtr(vp + 8 * KST + 64); const bf16x8 vb = __builtin_shufflevector(lo, hh2, 0, 1, 2, 3, 4, 5, 6, 7); o1 = ATT_MFMA(pa, vb, o1); }
        }
        LDS_WAIT(); asm volatile("" ::: "memory");
    }
    for (int kt = kt0; kt < NT; ++kt) {
        const int cur = kt & 1;
        {
            const LAS unsigned char* Kb = lds + L_K + cur * TILEB; const LAS unsigned char* Vb = lds + L_V + cur * TILEB;
            f32x16 s0, s1; const float ninit = -mref;
#pragma unroll
            for (int r = 0; r < 16; ++r) { s0[r] = ninit; s1[r] = ninit; }
#pragma unroll
            for (int ks = 0; ks < 4; ++ks) { const bf16x8 a0 = *(const LAS bf16x8*)(Kb + koff + ks * 32); const bf16x8 a1 = *(const LAS bf16x8*)(Kb + koff + 32 * KST + ks * 32);
                s0 = ATT_MFMA(a0, qr[ks], s0); s1 = ATT_MFMA(a1, qr[ks], s1); }
            const LAS float* lbp = LBs + (Sd0 - 68 * kt);
            float tm = -3.0e38f;
            float bv[16];
#pragma unroll
            for (int r = 0; r < 16; ++r) { const int c = (r & 3) + 8 * (r >> 2), mi = (r & 3) + 4 * ((r >> 2) & 1); bv[r] = lbp[-(c + (c >> 4)) - ((bwm >> mi) & 1)]; }
            LDS_WAIT(); asm volatile("" ::: "memory");
#pragma unroll
            for (int r = 0; r < 16; ++r) { asm volatile("" : "+v"(bv[r])); s0[r] += bv[r]; tm = fmaxf(tm, s0[r]); }
#pragma unroll
            for (int r = 0; r < 16; ++r) { const int c = (r & 3) + 8 * (r >> 2) + 32, mi = (r & 3) + 4 * ((r >> 2) & 1); bv[r] = lbp[-(c + (c >> 4)) - ((bwm >> mi) & 1)]; }
            LDS_WAIT(); asm volatile("" ::: "memory");
#pragma unroll
            for (int r = 0; r < 16; ++r) { asm volatile("" : "+v"(bv[r])); s1[r] += bv[r]; tm = fmaxf(tm, s1[r]); }
            tm = fmaxf(tm, __shfl_xor(tm, 32));
            if (first || __any(tm > 8.f)) {
                const float d = first ? tm : fmaxf(tm, 0.f);
                mref += d; const float f = __builtin_amdgcn_exp2f(-d); l *= f;
#pragma unroll
                for (int r = 0; r < 16; ++r) { s0[r] -= d; s1[r] -= d; }
                if (!first) {
                    if (hi == 0) wsf[r32] = f;
                    LDS_WAIT(); asm volatile("" ::: "memory");
#pragma unroll
                    for (int r = 0; r < 16; ++r) { const float fr = wsf[crow(r, hi)]; o0[r] *= fr; o1[r] *= fr; }
                    LDS_WAIT(); asm volatile("" ::: "memory");
                }
                first = false;
            }
            float ps = 0.f;
#pragma unroll
            for (int r = 0; r < 16; ++r) { s0[r] = __builtin_amdgcn_exp2f(s0[r]); s1[r] = __builtin_amdgcn_exp2f(s1[r]); ps += s0[r] + s1[r]; }
            l += ps;
#pragma unroll
            for (int mt = 0; mt < 2; ++mt)
#pragma unroll
                for (int s = 0; s < 2; ++s) {
                    v4u pw;
                    if (mt == 0) { pw.x = cvtpk(s0[8 * s], s0[8 * s + 1]); pw.y = cvtpk(s0[8 * s + 2], s0[8 * s + 3]); pw.z = cvtpk(s0[8 * s + 4], s0[8 * s + 5]); pw.w = cvtpk(s0[8 * s + 6], s0[8 * s + 7]); }
                    else { pw.x = cvtpk(s1[8 * s], s1[8 * s + 1]); pw.y = cvtpk(s1[8 * s + 2], s1[8 * s + 3]); pw.z = cvtpk(s1[8 * s + 4], s1[8 * s + 5]); pw.w = cvtpk(s1[8 * s + 6], s1[8 * s + 7]); }
                    const bf16x8 pa = __builtin_bit_cast(bf16x8, pw);
                    const LAS unsigned char* vp = Vb + voff + (32 * mt + 16 * s) * KST;
                    { const s16x4 lo = vtr(vp), hh2 = vtr(vp + 8 * KST); const bf16x8 vb = __builtin_shufflevector(lo, hh2, 0, 1, 2, 3, 4, 5, 6, 7); o0 = ATT_MFMA(pa, vb, o0); }
                    { const s16x4 lo = vtr(vp + 64), hh2 = vtr(vp + 8 * KST + 64); const bf16x8 vb = __builtin_shufflevector(lo, hh2, 0, 1, 2, 3, 4, 5, 6, 7); o1 = ATT_MFMA(pa, vb, o1); }
                }
        }
        if (kt + 1 < NT) {
            *(LAS v4u*)(lds + L_K + (cur ^ 1) * TILEB + soff) = kreg; *(LAS v4u*)(lds + L_V + (cur ^ 1) * TILEB + soff) = vreg;
            if (kt + 2 < NT) { kreg = *(const GAS v4u*)(kg + (size_t)(kt + 2) * 64 * NPROJ); vreg = *(const GAS v4u*)(vg + (size_t)(kt + 2) * 64 * NPROJ); }
        }
        __syncthreads();
    }
    { const float lt = l + __shfl_xor(l, 32); const float inv = 1.f / lt;
      if (hi == 0) wsf[r32] = inv;
      LDS_WAIT(); asm volatile("" ::: "memory");
      LAS unsigned char* ot = lds + L_K + w * 4608;
#pragma unroll
      for (int r = 0; r < 16; ++r) { const float fr = wsf[crow(r, hi)]; LAS unsigned short* orow_ = (LAS unsigned short*)(ot + crow(r, hi) * KST);
          orow_[r32] = (unsigned short)f2bf(o0[r] * fr); orow_[32 + r32] = (unsigned short)f2bf(o1[r] * fr); }
      LDS_WAIT(); asm volatile("" ::: "memory");
      { const int orw = lane >> 1, ohf = lane & 1; const LAS unsigned char* src = ot + orw * KST + 64 * ohf;
        unsigned char* op = F.MIX8 + (size_t)(rowb + q0 + 2 * w + (orw >> 4) + 16 * (orw & 15)) * DM + hh * 64 + 32 * ohf;
        const v4u a0_ = *(const LAS v4u*)src, a1_ = *(const LAS v4u*)(src + 16), a2_ = *(const LAS v4u*)(src + 32), a3_ = *(const LAS v4u*)(src + 48);
        v4u o0_, o1_; o0_.x = bf4_to_f8(a0_.x, a0_.y); o0_.y = bf4_to_f8(a0_.z, a0_.w); o0_.z = bf4_to_f8(a1_.x, a1_.y); o0_.w = bf4_to_f8(a1_.z, a1_.w);
        o1_.x = bf4_to_f8(a2_.x, a2_.y); o1_.y = bf4_to_f8(a2_.z, a2_.w); o1_.z = bf4_to_f8(a3_.x, a3_.y); o1_.w = bf4_to_f8(a3_.z, a3_.w);
        *(GAS v4u*)op = o0_; *(GAS v4u*)(op + 16) = o1_; }
      LDS_WAIT(); asm volatile("" ::: "memory"); }
}
template <class PostFn> __device__ __forceinline__ void attn_phase(Frame& F, gu32* qctr, int npre, PostFn post) {
    LAS int* uw = (LAS int*)(F.lds + 147456 - 1024);
    for (;;) {
        __syncthreads();
        if (F.tid == 0) *uw = (int)__hip_atomic_fetch_add(qctr, 1u, RLX_AGENT);
        __syncthreads();
        const int u0 = *uw;
        if (u0 >= npre + N_UNITS) break;
        if (u0 < npre) { post(u0); continue; }
        const int u = u0 - npre;
        const int qb = 7 - (u >> 7), bh = u & 127;
        attn_unit(F, bh >> 4, bh & 15, qb);
    }
}
}


namespace gla {
using att::f32x16; using att::s16x4; using att::vtr; using att::cvtpk; using att::crow;
constexpr int L_LA = 0;
constexpr int QST = 272;
constexpr int L_QT = 32768, L_QH = L_QT + 64 * QST, L_KH = L_QH + 64 * QST, L_KD = L_KH + 64 * QST;
constexpr int L_OST = L_QT, OSTF = 260;
constexpr int L_VS = 102400, VST = 528;
constexpr int L_SEG = 136192, L_DEC = L_SEG + 2048, L_GN = L_DEC + 512, L_END = L_GN + 1024;
constexpr int AST = 144;
#define GLA_MFMA(a, b, c) __builtin_amdgcn_mfma_f32_32x32x16_bf16((a), (b), (c), 0, 0, 0)
__device__ __forceinline__ bf16x8 pack8(const f32x16& x, int s) {
    v4u p; p.x = cvtpk(x[8 * s], x[8 * s + 1]); p.y = cvtpk(x[8 * s + 2], x[8 * s + 3]); p.z = cvtpk(x[8 * s + 4], x[8 * s + 5]); p.w = cvtpk(x[8 * s + 6], x[8 * s + 7]);
    return __builtin_bit_cast(bf16x8, p);
}
constexpr int REC_QT = 0, REC_AT = 64 * QST, REC_BYTES = REC_AT + 64 * AST;
constexpr size_t SCR_REC = 0, SCR_DEC = 28 * MiB, SCR_KV = 32 * MiB;
constexpr int NITEM = BATCH * NGH * (SEQ / 64);
constexpr int REC_PIECES = REC_BYTES / 16;
__device__ __forceinline__ void gla_pre_item(Frame& F, int b, int h, int n, int item) {
    LAS unsigned char* lds = F.lds;
    const int tid = F.tid, lane = F.lane, w = F.wave, r32 = lane & 31, hi = lane >> 5;
    const size_t rowb = (size_t)b * SEQ;
    const int gmt = w & 1, gnt = w >> 1;
    const int pt = tid >> 3, ps = tid & 7;
    LAS float* LA = (LAS float*)(lds + L_LA); LAS float* SEG = (LAS float*)(lds + L_SEG); LAS float* DEC = (LAS float*)(lds + L_DEC);
    bf16x8 wgf;
    { v4u t;
      t.x = pk2(F.wg2[(8 * hi + 0) * 512 + h * 128 + 32 * gnt + r32], F.wg2[(8 * hi + 1) * 512 + h * 128 + 32 * gnt + r32]);
      t.y = pk2(F.wg2[(8 * hi + 2) * 512 + h * 128 + 32 * gnt + r32], F.wg2[(8 * hi + 3) * 512 + h * 128 + 32 * gnt + r32]);
      t.z = pk2(F.wg2[(8 * hi + 4) * 512 + h * 128 + 32 * gnt + r32], F.wg2[(8 * hi + 5) * 512 + h * 128 + 32 * gnt + r32]);
      t.w = pk2(F.wg2[(8 * hi + 6) * 512 + h * 128 + 32 * gnt + r32], F.wg2[(8 * hi + 7) * 512 + h * 128 + 32 * gnt + r32]);
      wgf = __builtin_bit_cast(bf16x8, t); }
    const float gbias = F.bgate[h * 128 + 32 * gnt + r32];
    v4u pq[2], pk[2], pv[4]; f32x4 pga[2];
    { const float* ga_ = F.GA + (rowb + 64 * n + 32 * gmt + r32) * 16 + 8 * hi; pga[0] = *(const GAS f32x4*)ga_; pga[1] = *(const GAS f32x4*)(ga_ + 4);
      const bf16* pr_ = F.PROJ + (rowb + 64 * n + pt) * NPROJ;
      pq[0] = *(const GAS v4u*)(pr_ + C_GQ + h * 128 + 16 * ps); pq[1] = *(const GAS v4u*)(pr_ + C_GQ + h * 128 + 16 * ps + 8);
      pk[0] = *(const GAS v4u*)(pr_ + C_GK + h * 128 + 16 * ps); pk[1] = *(const GAS v4u*)(pr_ + C_GK + h * 128 + 16 * ps + 8);
#pragma unroll
      for (int i = 0; i < 4; ++i) pv[i] = *(const GAS v4u*)(pr_ + C_GV + h * 256 + 32 * ps + 8 * i); }
    { v4u ap; ap.x = pk2(pga[0].x, pga[0].y); ap.y = pk2(pga[0].z, pga[0].w); ap.z = pk2(pga[1].x, pga[1].y); ap.w = pk2(pga[1].z, pga[1].w);
      f32x16 z;
#pragma unroll
      for (int r = 0; r < 16; ++r) z[r] = 0.f;
      z = GLA_MFMA(__builtin_bit_cast(bf16x8, ap), wgf, z);
#pragma unroll
      for (int r = 0; r < 16; ++r) { float lg = z[r] + gbias; lg = fminf(fmaxf(lg, -80.f), 80.f);
          const float la2 = -__builtin_amdgcn_logf(1.f + __builtin_amdgcn_exp2f(-lg * LOG2E)) * (1.f / 16.f);
          LA[(32 * gmt + crow(r, hi)) * 128 + 32 * gnt + r32] = la2; } }
    __syncthreads();
    { const int c = tid & 127, seg = tid >> 7; float run = 0.f;
#pragma unroll
      for (int i = 0; i < 16; ++i) { run += LA[(16 * seg + i) * 128 + c]; LA[(16 * seg + i) * 128 + c] = run; }
      SEG[seg * 128 + c] = run; }
    __syncthreads();
    { const int c0 = 16 * ps, sg = pt >> 4;
      const int ro = pt * QST + c0 * 2;
#pragma unroll
      for (int i = 0; i < 4; ++i) {
          const f32x4 bb = *(const LAS f32x4*)(LA + pt * 128 + c0 + 4 * i);
          const f32x4 s0 = *(const LAS f32x4*)(SEG + c0 + 4 * i), s1 = *(const LAS f32x4*)(SEG + 128 + c0 + 4 * i), s2 = *(const LAS f32x4*)(SEG + 256 + c0 + 4 * i), s3 = *(const LAS f32x4*)(SEG + 384 + c0 + 4 * i);
          const f32x4 l31 = *(const LAS f32x4*)(LA + 31 * 128 + c0 + 4 * i);
          f32x4 pre = {0.f, 0.f, 0.f, 0.f}; if (sg > 0) pre += s0; if (sg > 1) pre += s1; if (sg > 2) pre += s2;
          const f32x4 bv = bb + pre, bref = l31 + s0, blast = (s0 + s1) + (s2 + s3);
          const unsigned qw0_ = (i < 2) ? (i == 0 ? pq[0].x : pq[0].z) : (i == 2 ? pq[1].x : pq[1].z), qw1_ = (i < 2) ? (i == 0 ? pq[0].y : pq[0].w) : (i == 2 ? pq[1].y : pq[1].w);
          const unsigned kw0_ = (i < 2) ? (i == 0 ? pk[0].x : pk[0].z) : (i == 2 ? pk[1].x : pk[1].z), kw1_ = (i < 2) ? (i == 0 ? pk[0].y : pk[0].w) : (i == 2 ? pk[1].y : pk[1].w);
          const float qv[4] = {bflo(qw0_) * GQSCALE, bfhi(qw0_) * GQSCALE, bflo(qw1_) * GQSCALE, bfhi(qw1_) * GQSCALE};
          const float kv[4] = {bflo(kw0_), bfhi(kw0_), bflo(kw1_), bfhi(kw1_)};
          float a_[4], b_[4], c_[4], d_[4];
#pragma unroll
          for (int e = 0; e < 4; ++e) { const float eb = __builtin_amdgcn_exp2f(bv[e]), e1 = __builtin_amdgcn_exp2f(bv[e] - bref[e]), e2 = __builtin_amdgcn_exp2f(bref[e] - bv[e]), e3 = __builtin_amdgcn_exp2f(blast[e] - bv[e]);
              a_[e] = qv[e] * eb; b_[e] = qv[e] * e1; c_[e] = kv[e] * e2; d_[e] = kv[e] * e3; }
          *(LAS v2u*)(lds + L_QT + ro + 8 * i) = (v2u){cvtpk(a_[0], a_[1]), cvtpk(a_[2], a_[3])}; *(LAS v2u*)(lds + L_QH + ro + 8 * i) = (v2u){cvtpk(b_[0], b_[1]), cvtpk(b_[2], b_[3])};
          *(LAS v2u*)(lds + L_KH + ro + 8 * i) = (v2u){cvtpk(c_[0], c_[1]), cvtpk(c_[2], c_[3])}; *(LAS v2u*)(lds + L_KD + ro + 8 * i) = (v2u){cvtpk(d_[0], d_[1]), cvtpk(d_[2], d_[3])};
          __builtin_amdgcn_sched_barrier(0);
          if (pt == 0) { f32x4 dv; dv.x = __builtin_amdgcn_exp2f(blast.x); dv.y = __builtin_amdgcn_exp2f(blast.y); dv.z = __builtin_amdgcn_exp2f(blast.z); dv.w = __builtin_amdgcn_exp2f(blast.w); *(LAS f32x4*)(DEC + c0 + 4 * i) = dv; }
      }
#pragma unroll
      for (int i = 0; i < 4; ++i) *(LAS v4u*)(lds + L_VS + pt * VST + 64 * ps + 16 * i) = pv[i]; }
    __syncthreads();
    if (w < 3) { const int jt = (w == 2) ? 1 : 0, it = (w >= 1) ? 1 : 0;
        f32x16 x;
#pragma unroll
        for (int r = 0; r < 16; ++r) x[r] = 0.f;
#pragma unroll
        for (int ks = 0; ks < 8; ++ks) { const bf16x8 a = *(const LAS bf16x8*)(lds + L_KH + (32 * jt + r32) * QST + (16 * ks + 8 * hi) * 2);
            const bf16x8 bq = *(const LAS bf16x8*)(lds + L_QH + (32 * it + r32) * QST + (16 * ks + 8 * hi) * 2); x = GLA_MFMA(a, bq, x); }
        const int i = 32 * it + r32;
#pragma unroll
        for (int g = 0; g < 4; ++g) { const int j0 = 32 * jt + 8 * g + 4 * hi;
            const float v0 = (j0 + 0 <= i) ? x[4 * g + 0] : 0.f, v1 = (j0 + 1 <= i) ? x[4 * g + 1] : 0.f, v2 = (j0 + 2 <= i) ? x[4 * g + 2] : 0.f, v3 = (j0 + 3 <= i) ? x[4 * g + 3] : 0.f;
            v2u pw; pw.x = cvtpk(v0, v1); pw.y = cvtpk(v2, v3); *(LAS v2u*)(lds + L_LA + i * AST + j0 * 2) = pw; }
    } else if (w == 3) { const v4u zz = {0u, 0u, 0u, 0u}; *(LAS v4u*)(lds + L_LA + r32 * AST + 64 + hi * 32) = zz; *(LAS v4u*)(lds + L_LA + r32 * AST + 64 + hi * 32 + 16) = zz; }
    __syncthreads();
    { const int q4 = (lane & 15) >> 2, p4 = lane & 3, blk = (lane >> 4) & 1;
      unsigned char* kvp = (unsigned char*)F.out + SCR_KV + (size_t)item * (256 * 128 * 2) + (size_t)(32 * w + r32) * 256;
      bf16x8 vf[4];
#pragma unroll
      for (int s = 0; s < 4; ++s) { const LAS unsigned char* vp_ = lds + L_VS + (16 * s + 8 * hi + q4) * VST + (32 * w + 16 * blk + 4 * p4) * 2; const s16x4 lo_ = vtr(vp_), hi_ = vtr(vp_ + 4 * VST); vf[s] = __builtin_shufflevector(lo_, hi_, 0, 1, 2, 3, 4, 5, 6, 7); }
#pragma unroll
      for (int ct = 0; ct < 4; ++ct) { f32x16 acc;
#pragma unroll
          for (int r = 0; r < 16; ++r) acc[r] = 0.f;
#pragma unroll
          for (int s = 0; s < 4; ++s) { const LAS unsigned char* kp = lds + L_KD + (16 * s + 8 * hi + q4) * QST + (32 * ct + 16 * blk + 4 * p4) * 2;
              const s16x4 lo = vtr(kp), hh2 = vtr(kp + 4 * QST); const bf16x8 af = __builtin_shufflevector(lo, hh2, 0, 1, 2, 3, 4, 5, 6, 7); acc = GLA_MFMA(af, vf[s], acc); }
#pragma unroll
          for (int g = 0; g < 4; ++g) { v2u pw; pw.x = cvtpk(acc[4 * g], acc[4 * g + 1]); pw.y = cvtpk(acc[4 * g + 2], acc[4 * g + 3]); *(GAS v2u*)(kvp + (32 * ct + 8 * g + 4 * hi) * 2) = pw; } } }
    { unsigned char* rec = (unsigned char*)F.out + SCR_REC + (size_t)item * REC_BYTES;
      for (int p = tid; p < REC_BYTES / 16; p += 512) { const int off = p * 16; const int src = off < REC_AT ? (L_QT + off) : (L_LA + off - REC_AT); *(GAS v4u*)(rec + off) = *(const LAS v4u*)(lds + src); }
      if (tid < 32) *(GAS f32x4*)((unsigned char*)F.out + SCR_DEC + (size_t)item * 512 + tid * 16) = *(const LAS f32x4*)(lds + L_DEC + tid * 16); }
    __syncthreads();
}
__device__ __forceinline__ void gla_scan(Frame& F) {
#pragma unroll 1
    for (int g = F.vcu * (NWAVES * 64) + F.tid; g < BATCH * NGH * 4096; g += F.G * NWAVES * 64) {
        const int bh = g >> 12, piece = g & 4095, c8 = (piece & 15) * 8;
        unsigned char* kv = (unsigned char*)F.out + SCR_KV + (size_t)bh * (SEQ / 64) * (256 * 128 * 2) + (size_t)piece * 16;
        const unsigned char* dc = (const unsigned char*)F.out + SCR_DEC + (size_t)bh * (SEQ / 64) * 512 + c8 * 4;
        float st[8];
#pragma unroll
        for (int j = 0; j < 8; ++j) st[j] = 0.f;
#pragma unroll 8
        for (int n = 0; n < SEQ / 64; ++n) {
            const v4u kw = *(const GAS v4u*)(kv + (size_t)n * (256 * 128 * 2));
            const f32x4 d0 = *(const GAS f32x4*)(dc + n * 512), d1 = *(const GAS f32x4*)(dc + n * 512 + 16);
            v4u ow; ow.x = cvtpk(st[0], st[1]); ow.y = cvtpk(st[2], st[3]); ow.z = cvtpk(st[4], st[5]); ow.w = cvtpk(st[6], st[7]);
            *(GAS v4u*)(kv + (size_t)n * (256 * 128 * 2)) = ow;
            st[0] = d0.x * st[0] + bflo(kw.x); st[1] = d0.y * st[1] + bfhi(kw.x); st[2] = d0.z * st[2] + bflo(kw.y); st[3] = d0.w * st[3] + bfhi(kw.y);
            st[4] = d1.x * st[4] + bflo(kw.z); st[5] = d1.y * st[5] + bfhi(kw.z); st[6] = d1.z * st[6] + bflo(kw.w); st[7] = d1.w * st[7] + bfhi(kw.w);
        }
    }
}
constexpr int P_REC = 0, P_VS = REC_BYTES, P_OST = P_VS + 64 * VST, P_GN = P_OST + 64 * OSTF * 4, P_END = P_GN + 1024;
__device__ __forceinline__ void gla_post_item(Frame& F, int b, int h, int n, int item) {
    LAS unsigned char* lds = F.lds;
    const int tid = F.tid, lane = F.lane, w = F.wave, r32 = lane & 31, hi = lane >> 5, q4 = (lane & 15) >> 2, p4 = lane & 3, blk = (lane >> 4) & 1, pt = tid >> 3, ps = tid & 7;
    const size_t rowb = (size_t)b * SEQ;
    LAS float* OST = (LAS float*)(lds + P_OST);
    __syncthreads();
    bf16x8 sf[8];
    { const unsigned char* sp = (const unsigned char*)F.out + SCR_KV + (size_t)item * (256 * 128 * 2) + (size_t)(32 * w + r32) * 256 + 16 * hi;
#pragma unroll
      for (int ks = 0; ks < 8; ++ks) sf[ks] = *(const GAS bf16x8*)(sp + 32 * ks); }
    { const unsigned char* rec = (const unsigned char*)F.out + SCR_REC + (size_t)item * REC_BYTES;
      v4u rc_[4];
#pragma unroll
      for (int k = 0; k < 4; ++k) { const int p = tid + 512 * k; rc_[k] = (p < REC_BYTES / 16) ? *(const GAS v4u*)(rec + p * 16) : (v4u){0u, 0u, 0u, 0u}; }
#pragma unroll
      for (int k = 0; k < 4; ++k) { const int p = tid + 512 * k; if (p < REC_BYTES / 16) *(LAS v4u*)(lds + P_REC + p * 16) = rc_[k]; }
      const bf16* pr_ = F.PROJ + (rowb + 64 * n + pt) * NPROJ;
#pragma unroll
      for (int i = 0; i < 4; ++i) *(LAS v4u*)(lds + P_VS + pt * VST + 64 * ps + 16 * i) = *(const GAS v4u*)(pr_ + C_GV + h * 256 + 32 * ps + 8 * i);
      if (tid < 256) ((LAS float*)(lds + P_GN))[tid] = F.gng[h * 256 + tid]; }
    v4u gr_[4];
    { const bf16* pr_ = F.PROJ + (rowb + 64 * n + pt) * NPROJ + C_GR + h * 256 + 32 * ps;
#pragma unroll
      for (int i = 0; i < 4; ++i) gr_[i] = *(const GAS v4u*)(pr_ + 8 * i); }
    __syncthreads();
    f32x16 o0, o1;
#pragma unroll
    for (int r = 0; r < 16; ++r) { o0[r] = 0.f; o1[r] = 0.f; }
#pragma unroll
    for (int ks = 0; ks < 8; ++ks) {
        const bf16x8 a0 = *(const LAS bf16x8*)(lds + P_REC + REC_QT + r32 * QST + (16 * ks + 8 * hi) * 2), a1 = *(const LAS bf16x8*)(lds + P_REC + REC_QT + (32 + r32) * QST + (16 * ks + 8 * hi) * 2);
        o0 = GLA_MFMA(a0, sf[ks], o0); o1 = GLA_MFMA(a1, sf[ks], o1); }
#pragma unroll
    for (int s = 0; s < 4; ++s) {
        const LAS unsigned char* vp_ = lds + P_VS + (16 * s + 8 * hi + q4) * VST + (32 * w + 16 * blk + 4 * p4) * 2; const s16x4 lo_ = vtr(vp_), hi_ = vtr(vp_ + 4 * VST);
        const bf16x8 vf = __builtin_shufflevector(lo_, hi_, 0, 1, 2, 3, 4, 5, 6, 7);
        if (s < 2) { const bf16x8 a = *(const LAS bf16x8*)(lds + P_REC + REC_AT + r32 * AST + (16 * s + 8 * hi) * 2); o0 = GLA_MFMA(a, vf, o0); }
        { const bf16x8 a = *(const LAS bf16x8*)(lds + P_REC + REC_AT + (32 + r32) * AST + (16 * s + 8 * hi) * 2); o1 = GLA_MFMA(a, vf, o1); }
    }
#pragma unroll
    for (int r = 0; r < 16; ++r) { OST[crow(r, hi) * OSTF + 32 * w + r32] = o0[r]; OST[(32 + crow(r, hi)) * OSTF + 32 * w + r32] = o1[r]; }
    __syncthreads();
    { f32x4 ov[8]; float ss = 0.f;
#pragma unroll
      for (int i = 0; i < 8; ++i) { ov[i] = *(const LAS f32x4*)(OST + pt * OSTF + 32 * ps + 4 * i); ss += (ov[i].x * ov[i].x + ov[i].y * ov[i].y) + (ov[i].z * ov[i].z + ov[i].w * ov[i].w); }
      ss += __shfl_xor(ss, 1); ss += __shfl_xor(ss, 2); ss += __shfl_xor(ss, 4);
      const float rstd = rsqrtf(ss * (1.f / 256.f) + EPS);
      unsigned char* op = F.MIX8 + (size_t)(rowb + 64 * n + pt) * DM + 1024 + h * 256 + 32 * ps;
      const LAS float* gp = (const LAS float*)(lds + P_GN) + 32 * ps;
#pragma unroll
      for (int i = 0; i < 4; ++i) { const f32x4 g0 = *(const LAS f32x4*)(gp + 8 * i), g1 = *(const LAS f32x4*)(gp + 8 * i + 4); const v4u gw = gr_[i];
          float y[8]; const float grv[8] = {bflo(gw.x), bfhi(gw.x), bflo(gw.y), bfhi(gw.y), bflo(gw.z), bfhi(gw.z), bflo(gw.w), bfhi(gw.w)};
          const float ovv[8] = {ov[2 * i].x, ov[2 * i].y, ov[2 * i].z, ov[2 * i].w, ov[2 * i + 1].x, ov[2 * i + 1].y, ov[2 * i + 1].z, ov[2 * i + 1].w};
          const float gg[8] = {g0.x, g0.y, g0.z, g0.w, g1.x, g1.y, g1.z, g1.w};
#pragma unroll
          for (int e = 0; e < 8; ++e) { const float sil = grv[e] * __builtin_amdgcn_rcpf(1.f + __builtin_amdgcn_exp2f(-grv[e] * LOG2E)); y[e] = ovv[e] * rstd * gg[e] * sil; }
          int w0 = 0, w1 = 0; w0 = __builtin_amdgcn_cvt_pk_fp8_f32(y[0] * MIX8_SCALE, y[1] * MIX8_SCALE, w0, false); w0 = __builtin_amdgcn_cvt_pk_fp8_f32(y[2] * MIX8_SCALE, y[3] * MIX8_SCALE, w0, true);
          w1 = __builtin_amdgcn_cvt_pk_fp8_f32(y[4] * MIX8_SCALE, y[5] * MIX8_SCALE, w1, false); w1 = __builtin_amdgcn_cvt_pk_fp8_f32(y[6] * MIX8_SCALE, y[7] * MIX8_SCALE, w1, true);
          *(GAS v2u*)(op + 8 * i) = (v2u){(unsigned)w0, (unsigned)w1}; } }
}
}

namespace pks {
using att::f32x16; using att::crow;
constexpr int KROW = 272;
constexpr int L_K1 = 0, L_K2 = 128 * KROW, L_TAB = 2 * 128 * KROW;
#define PK_MFMA(a, b, c) __builtin_amdgcn_mfma_f32_32x32x16_bf16((a), (b), (c), 0, 0, 0)
#define PK_CE(a, b) do { const float hi_ = fmaxf((a), (b)), lo_ = fminf((a), (b)); (a) = hi_; (b) = lo_; } while (0)
__device__ __forceinline__ void sort16(float (&x)[16]) {
#pragma unroll
    for (int k = 2; k <= 16; k <<= 1)
#pragma unroll
        for (int j = k >> 1; j > 0; j >>= 1)
#pragma unroll
            for (int i = 0; i < 16; ++i) { const int l = i ^ j; if (l > i) { if ((i & k) == 0) PK_CE(x[i], x[l]); else PK_CE(x[l], x[i]); } }
}
__device__ __forceinline__ void merge16(float (&t)[16], const float (&g)[16]) {
#pragma unroll
    for (int i = 0; i < 16; ++i) t[i] = fmaxf(t[i], g[15 - i]);
#pragma unroll
    for (int j = 8; j > 0; j >>= 1)
#pragma unroll
        for (int i = 0; i < 16; ++i) { const int l = i ^ j; if (l > i) PK_CE(t[i], t[l]); }
}
__device__ __forceinline__ float packid(float v, unsigned id, unsigned mask) { return __builtin_bit_cast(float, (__builtin_bit_cast(unsigned, v) & ~mask) | id); }
__device__ __forceinline__ float clearid(float v, unsigned mask) { return __builtin_bit_cast(float, __builtin_bit_cast(unsigned, v) & ~mask); }
__device__ __forceinline__ void set_top16(Frame& F, const bf16* qbase, int ktab, float (&T)[16], int lane) {
    const int r32 = lane & 31, hi = lane >> 5;
    f32x16 acc[4];
#pragma unroll
    for (int mt = 0; mt < 4; ++mt)
#pragma unroll
        for (int r = 0; r < 16; ++r) acc[mt][r] = 0.f;
#pragma unroll
    for (int ks = 0; ks < 8; ++ks) {
        const bf16x8 qf = *(const GAS bf16x8*)(qbase + 16 * ks + 8 * hi);
#pragma unroll
        for (int mt = 0; mt < 4; ++mt) { const bf16x8 kf = *(const LAS bf16x8*)(F.lds + ktab + (32 * mt + r32) * KROW + (16 * ks + 8 * hi) * 2); acc[mt] = PK_MFMA(kf, qf, acc[mt]); }
    }
    float g[16];
#pragma unroll
    for (int mt = 0; mt < 4; ++mt) {
#pragma unroll
        for (int r = 0; r < 16; ++r) g[r] = packid(acc[mt][r], (unsigned)(32 * mt + crow(r, hi)), 127u);
        sort16(g);
        if (mt == 0) {
#pragma unroll
            for (int r = 0; r < 16; ++r) T[r] = g[r];
        } else merge16(T, g);
    }
#pragma unroll
    for (int r = 0; r < 16; ++r) g[r] = __shfl_xor(T[r], 32);
    merge16(T, g);
}
__device__ __forceinline__ void peer_score(Frame& F) {
    const int tid = F.tid, lane = F.lane, w = F.wave, r32 = lane & 31, hi = lane >> 5;
    { f32x4 kv_[16];
#pragma unroll
      for (int j = 0; j < 16; ++j) { const int i = tid + 512 * j, s = i >> 12, row = (i >> 5) & 127, c4 = i & 31; kv_[j] = *(const GAS f32x4*)((s ? F.keys2 : F.keys1) + row * 128 + 4 * c4); }
#pragma unroll
      for (int j = 0; j < 16; ++j) { const int i = tid + 512 * j, s = i >> 12, row = (i >> 5) & 127, c4 = i & 31; const f32x4 v = kv_[j];
        v2u o; o.x = pk2(v.x, v.y); o.y = pk2(v.z, v.w); *(LAS v2u*)(F.lds + (s ? L_K2 : L_K1) + row * KROW + 8 * c4) = o; } }
    __syncthreads();
    LAS unsigned char* tab = F.lds + L_TAB + w * 2304 + lane * 36;
    const float NEG = -3.0e38f;
    for (int task = 2 * (int)blockIdx.x * PEH + w; task < (T / 32) * PEH; task += (task & 8) ? (2 * F.G - 1) * PEH : PEH) {
        const int tg = task >> 3, hp = task & 7; const int m = tg * 32 + r32;
        const bf16* q = F.PQ + (size_t)m * DM + hp * 256;
        float rstd;
        { float s_ = 0.f;
#pragma unroll
          for (int k = 0; k < 16; ++k) s_ += F.SSQ[(size_t)(16 * hi + k) * T + m];
          s_ += __shfl_xor(s_, 32); rstd = rsqrtf(s_ * (1.f / DM) + EPS); if (hp == 0 && hi == 0) F.RSTD[m] = rstd; }
        float T1[16], T2[16];
        set_top16(F, q, L_K1, T1, lane);
        set_top16(F, q + 128, L_K2, T2, lane);
        { v4u a, c;
          a.x = (__builtin_bit_cast(unsigned, T1[0]) & 127u) | ((__builtin_bit_cast(unsigned, T1[1]) & 127u) << 8) | ((__builtin_bit_cast(unsigned, T1[2]) & 127u) << 16) | ((__builtin_bit_cast(unsigned, T1[3]) & 127u) << 24);
          a.y = (__builtin_bit_cast(unsigned, T1[4]) & 127u) | ((__builtin_bit_cast(unsigned, T1[5]) & 127u) << 8) | ((__builtin_bit_cast(unsigned, T1[6]) & 127u) << 16) | ((__builtin_bit_cast(unsigned, T1[7]) & 127u) << 24);
          a.z = (__builtin_bit_cast(unsigned, T1[8]) & 127u) | ((__builtin_bit_cast(unsigned, T1[9]) & 127u) << 8) | ((__builtin_bit_cast(unsigned, T1[10]) & 127u) << 16) | ((__builtin_bit_cast(unsigned, T1[11]) & 127u) << 24);
          a.w = (__builtin_bit_cast(unsigned, T1[12]) & 127u) | ((__builtin_bit_cast(unsigned, T1[13]) & 127u) << 8) | ((__builtin_bit_cast(unsigned, T1[14]) & 127u) << 16) | ((__builtin_bit_cast(unsigned, T1[15]) & 127u) << 24);
          c.x = (__builtin_bit_cast(unsigned, T2[0]) & 127u) | ((__builtin_bit_cast(unsigned, T2[1]) & 127u) << 8) | ((__builtin_bit_cast(unsigned, T2[2]) & 127u) << 16) | ((__builtin_bit_cast(unsigned, T2[3]) & 127u) << 24);
          c.y = (__builtin_bit_cast(unsigned, T2[4]) & 127u) | ((__builtin_bit_cast(unsigned, T2[5]) & 127u) << 8) | ((__builtin_bit_cast(unsigned, T2[6]) & 127u) << 16) | ((__builtin_bit_cast(unsigned, T2[7]) & 127u) << 24);
          c.z = (__builtin_bit_cast(unsigned, T2[8]) & 127u) | ((__builtin_bit_cast(unsigned, T2[9]) & 127u) << 8) | ((__builtin_bit_cast(unsigned, T2[10]) & 127u) << 16) | ((__builtin_bit_cast(unsigned, T2[11]) & 127u) << 24);
          c.w = (__builtin_bit_cast(unsigned, T2[12]) & 127u) | ((__builtin_bit_cast(unsigned, T2[13]) & 127u) << 8) | ((__builtin_bit_cast(unsigned, T2[14]) & 127u) << 16) | ((__builtin_bit_cast(unsigned, T2[15]) & 127u) << 24);
          LAS unsigned* tw = (LAS unsigned*)tab;
          tw[0] = a.x; tw[1] = a.y; tw[2] = a.z; tw[3] = a.w; tw[4] = c.x; tw[5] = c.y; tw[6] = c.z; tw[7] = c.w; }
        float a_[16], b_[16];
#pragma unroll
        for (int i = 0; i < 16; ++i) { a_[i] = clearid(T1[i], 127u); b_[i] = clearid(T2[i], 127u); }
        float C[16], G[16];
#pragma unroll
        for (int j = 0; j < 16; ++j) C[j] = packid(a_[0] + b_[j], (unsigned)j, 255u);
        { int n = 0;
#pragma unroll
          for (int j = 0; j < 8; ++j) G[n++] = packid(a_[1] + b_[j], 16u + j, 255u);
#pragma unroll
          for (int j = 0; j < 5; ++j) G[n++] = packid(a_[2] + b_[j], 32u + j, 255u);
#pragma unroll
          for (int j = 0; j < 3; ++j) G[n++] = packid(a_[3] + b_[j], 48u + j, 255u);
          sort16(G); merge16(C, G); }
        { int n = 0;
          G[n++] = packid(a_[3] + b_[3], 48u + 3u, 255u);
#pragma unroll
          for (int j = 0; j < 3; ++j) G[n++] = packid(a_[4] + b_[j], 64u + j, 255u);
#pragma unroll
          for (int i = 5; i < 8; ++i) { G[n++] = packid(a_[i] + b_[0], 16u * i, 255u); G[n++] = packid(a_[i] + b_[1], 16u * i + 1u, 255u); }
#pragma unroll
          for (int i = 8; i < 14; ++i) G[n++] = packid(a_[i] + b_[0], 16u * i, 255u);
          sort16(G); merge16(C, G); }
        {
          G[0] = packid(a_[14] + b_[0], 16u * 14u, 255u); G[1] = packid(a_[15] + b_[0], 16u * 15u, 255u); if (G[1] > G[0]) { const float t_ = G[0]; G[0] = G[1]; G[1] = t_; }
#pragma unroll
          for (int i = 2; i < 16; ++i) G[i] = NEG;
          merge16(C, G); }
        const float mx = clearid(C[0], 255u);
        float e[16], sum = 0.f;
#pragma unroll
        for (int k = 0; k < 16; ++k) { e[k] = __builtin_amdgcn_exp2f((clearid(C[k], 255u) - mx) * (LOG2E * rstd)); sum += e[k]; }
        const float inv = 1.f / sum;
        LDS_WAIT(); asm volatile("" ::: "memory");
        int eo[8]; float go[8];
        { int k1_[8], k2_[8];
#pragma unroll
          for (int kk = 0; kk < 8; ++kk) { const float cv = hi ? C[8 + kk] : C[kk]; const unsigned id = __builtin_bit_cast(unsigned, cv) & 255u; k1_[kk] = tab[id >> 4]; k2_[kk] = tab[16 + (id & 15)]; }
          LDS_WAIT(); asm volatile("" ::: "memory");
#pragma unroll
          for (int kk = 0; kk < 8; ++kk) { asm volatile("" : "+v"(k1_[kk]), "+v"(k2_[kk])); eo[kk] = k1_[kk] * PEK + k2_[kk]; go[kk] = (hi ? e[8 + kk] : e[kk]) * inv; } }
        int* ip = F.IDX + (size_t)m * 128 + hp * 16 + 8 * hi; float* gp = F.GATE + (size_t)m * 128 + hp * 16 + 8 * hi;
        *(GAS v4u*)ip = (v4u){(unsigned)eo[0], (unsigned)eo[1], (unsigned)eo[2], (unsigned)eo[3]}; *(GAS v4u*)(ip + 4) = (v4u){(unsigned)eo[4], (unsigned)eo[5], (unsigned)eo[6], (unsigned)eo[7]};
        *(GAS f32x4*)gp = (f32x4){go[0], go[1], go[2], go[3]}; *(GAS f32x4*)(gp + 4) = (f32x4){go[4], go[5], go[6], go[7]};
        LDS_WAIT(); asm volatile("" ::: "memory");
    }
}
}

typedef float f32x2 __attribute__((ext_vector_type(2)));
__device__ __forceinline__ float gelu_erf(float v) {
    const float av = fabsf(v), t = __builtin_amdgcn_rcpf(av * 0.2316418882f + 1.0f);
    float q = t * 0.5307027145f + (-0.7265760135f); q = q * t + 0.7107068705f; q = q * t + (-0.142248368f); q = q * t + 0.127414796f; q = q * t;
    const float e = __builtin_amdgcn_exp2f((v * v) * (-0.72134752044f));
    const float mm = v * (q * e);
    return v < 0.f ? mm : v - mm;
}
namespace pex {
constexpr int L_IDX = 0, L_H = 32768, L_SS = 65536, L_RS = 81920, L_XS = 82176;
#define PX_DPP(v, ctrl) __builtin_bit_cast(float, __builtin_amdgcn_update_dpp(0, __builtin_bit_cast(int, (v)), (ctrl), 0xF, 0xF, true))
__device__ __forceinline__ float red8(float v) { v += PX_DPP(v, 0xB1); v += PX_DPP(v, 0x4E); v += PX_DPP(v, 0x141); return v; }
__device__ __forceinline__ float redpg(float v) {
    v += PX_DPP(v, 0x128); v += __shfl_xor(v, 16); v += __shfl_xor(v, 32);
    return v;
}
#define PX_CVT(w_, hi_) __builtin_amdgcn_cvt_pk_f32_fp8((int)(w_), (hi_))
__device__ __forceinline__ void peer_experts(Frame& F) {
    const int tid = F.tid, lane = F.lane, w = F.wave, seg = lane & 7, pg = lane >> 3;
    LAS unsigned* IDX2 = (LAS unsigned*)(F.lds + L_IDX); LAS float* H2 = (LAS float*)(F.lds + L_H); LAS float* SSL = (LAS float*)(F.lds + L_SS); LAS float* RSL = (LAS float*)(F.lds + L_RS);
    const bf16* HN = F.HN;
    for (int tile = (int)blockIdx.x; tile < T / 64; tile += F.G) {
        const int m0 = tile * 64;
        for (int i = tid; i < 64 * 64; i += 512) SSL[i] = 0.f;
        { int iv_[16];
#pragma unroll
          for (int j = 0; j < 16; ++j) iv_[j] = F.IDX[(size_t)m0 * 128 + tid + 512 * j];
#pragma unroll
          for (int j = 0; j < 16; ++j) { const int i = tid + 512 * j, t = i >> 7, p = i & 127; IDX2[t * 128 + (p & 7) * 16 + (p >> 3)] = (unsigned)iv_[j] * 128u; } }
        if (tid < 64) RSL[tid] = F.RSTD[m0 + tid];
        { LAS float* XSL = (LAS float*)(F.lds + L_XS);
#pragma unroll 1
          for (int hb = 0; hb < 2; ++hb) {
            v4u rw[4][4];
#pragma unroll
            for (int t4 = 0; t4 < 4; ++t4)
#pragma unroll
                for (int i = 0; i < 4; ++i) rw[t4][i] = *(const GAS v4u*)((const unsigned char*)(HN + (size_t)(m0 + 8 * w + 4 * hb + t4) * DM) + 64 * lane + 16 * i);
#pragma unroll
            for (int t4 = 0; t4 < 4; ++t4) { float am = 0.f;
#pragma unroll
                for (int i = 0; i < 4; ++i) { const v4u q = rw[t4][i];
                    am = fmaxf(am, fmaxf(fmaxf(fmaxf(fabsf(bflo(q.x)), fabsf(bfhi(q.x))), fmaxf(fabsf(bflo(q.y)), fabsf(bfhi(q.y)))), fmaxf(fmaxf(fabsf(bflo(q.z)), fabsf(bfhi(q.z))), fmaxf(fabsf(bflo(q.w)), fabsf(bfhi(q.w)))))); }
                am = wave_max(am);
                const float xs = fmaxf(am, 1e-30f) * (1.f / 127.f), xi = 1.f / xs;
                v4u o[2];
#pragma unroll
                for (int i = 0; i < 4; ++i) { const v4u q = rw[t4][i];
                    const unsigned lo = q8pack(bflo(q.x) * xi, bfhi(q.x) * xi, bflo(q.y) * xi, bfhi(q.y) * xi), hi2 = q8pack(bflo(q.z) * xi, bfhi(q.z) * xi, bflo(q.w) * xi, bfhi(q.w) * xi);
                    if (i == 0) { o[0].x = lo; o[0].y = hi2; } else if (i == 1) { o[0].z = lo; o[0].w = hi2; } else if (i == 2) { o[1].x = lo; o[1].y = hi2; } else { o[1].z = lo; o[1].w = hi2; } }
                unsigned char* qrow = F.XQ8 + (size_t)(m0 + 8 * w + 4 * hb + t4) * DM + 32 * lane;
                *(GAS v4u*)qrow = o[0]; *(GAS v4u*)(qrow + 16) = o[1];
                if (lane == 0) XSL[8 * w + 4 * hb + t4] = xs; } }
          asm volatile("s_waitcnt vmcnt(0)" ::: "memory"); }
        __syncthreads();
        v4u RA[8], RB[8], XA[2], XB[2];
        const bool sb0 = (seg & 1) != 0, sb1 = (seg & 2) != 0, sb2 = (seg & 4) != 0, pb0 = (pg & 1) != 0, pb1 = (pg & 2) != 0, pb2 = (pg & 4) != 0;
        const int krev = 4 * (seg & 1) + (seg & 2) + ((seg >> 2) & 1), jcol = 8 * (pg & 1) + 2 * (pg & 2) + ((pg >> 1) & 2);
        const unsigned seg16 = 16u * seg, seg32 = 32u * seg, seg64 = 64u * seg; const int pg4 = 4 * pg;
#define PX_LOAD8(TB, R, s_, tt_, hf_) do { const unsigned char* b_ = (TB) + (size_t)(s_) * NEXP * 128; const LAS v4u* ip_ = (const LAS v4u*)(IDX2 + (8 * w + (tt_)) * 128 + 8 * (hf_)) + pg4; \
            const v4u i0_ = ip_[0] + seg16, i1_ = ip_[1] + seg16; \
            R[0] = *(const GAS v4u*)(b_ + i0_.x); R[1] = *(const GAS v4u*)(b_ + i0_.y); R[2] = *(const GAS v4u*)(b_ + i0_.z); R[3] = *(const GAS v4u*)(b_ + i0_.w); \
            R[4] = *(const GAS v4u*)(b_ + i1_.x); R[5] = *(const GAS v4u*)(b_ + i1_.y); R[6] = *(const GAS v4u*)(b_ + i1_.z); R[7] = *(const GAS v4u*)(b_ + i1_.w); } while (0)
#define PX_LOADX(X, s_, tt_) do { X[0] = *(const GAS v4u*)(F.XQ8 + (size_t)(m0 + 8 * w + (tt_)) * DM + 128 * (s_) + seg16); } while (0)
        for (int i = tid; i < 64 * 128; i += 512) H2[i] = 0.f;
        __syncthreads();
#define PX_DOT8(R, XC_, own_) do { float d_[8]; \
            _Pragma("unroll") for (int k = 0; k < 8; ++k) { int a_ = __builtin_amdgcn_sdot4((int)R[k].x, (int)XC_[0].x, 0, false); a_ = __builtin_amdgcn_sdot4((int)R[k].y, (int)XC_[0].y, a_, false); \
                a_ = __builtin_amdgcn_sdot4((int)R[k].z, (int)XC_[0].z, a_, false); a_ = __builtin_amdgcn_sdot4((int)R[k].w, (int)XC_[0].w, a_, false); d_[k] = (float)a_; } \
            float e_[4], f_[2]; \
            _Pragma("unroll") for (int k = 0; k < 4; ++k) { const float snd_ = sb0 ? d_[k] : d_[k + 4], kp_ = sb0 ? d_[k + 4] : d_[k]; e_[k] = kp_ + PX_DPP(snd_, 0xB1); } \
            _Pragma("unroll") for (int k = 0; k < 2; ++k) { const float snd_ = sb1 ? e_[k] : e_[k + 2], kp_ = sb1 ? e_[k + 2] : e_[k]; f_[k] = kp_ + PX_DPP(snd_, 0x4E); } \
            { const float snd_ = sb2 ? f_[0] : f_[1], kp_ = sb2 ? f_[1] : f_[0]; own_ = kp_ + __shfl_xor(snd_, 4); } \
            __builtin_amdgcn_sched_barrier(0); } while (0)
#define PX_TOK1(tt, XC, XN_) do { PX_LOAD8(F.U8, RB, s, (tt), 1); __builtin_amdgcn_sched_barrier(0); \
            float own0_, own1_; \
            PX_DOT8(RA, XC, own0_); \
            { const int tn_ = ((tt) + 1) & 7, sn_ = s + (((tt) + 1) >> 3); if (sn_ < 16) { PX_LOAD8(F.U8, RA, sn_, tn_, 0); PX_LOADX(XN_, sn_, tn_); } } \
            __builtin_amdgcn_sched_barrier(0); PX_DOT8(RB, XC, own1_); \
            { LAS float* hp2_ = H2 + (8 * w + (tt)) * 128 + pg * 16 + krev; hp2_[0] += own0_; hp2_[8] += own1_; } } while (0)
        PX_LOAD8(F.U8, RA, 0, 0, 0); PX_LOADX(XA, 0, 0);
#pragma unroll 1
        for (int s = 0; s < 16; ++s) {
#pragma unroll 1
            for (int tp = 0; tp < 8; tp += 2) { PX_TOK1(tp, XA, XB); PX_TOK1(tp + 1, XB, XA); }
        }
#undef PX_TOK1
#undef PX_DOT8
        LDS_WAIT(); asm volatile("" ::: "memory");
        { float su_[16], sv_[16], gt_[16];
#pragma unroll
          for (int q = 0; q < 16; ++q) { const int t = 8 * w + (q >> 1), ii = krev + 8 * (q & 1), p = 8 * ii + pg; const int e = (int)(IDX2[t * 128 + pg * 16 + ii] >> 7);
              su_[q] = F.SC[e] * (RSL[t] * ((LAS float*)(F.lds + L_XS))[t]); sv_[q] = F.SC[NEXP + e]; gt_[q] = F.GATE[(size_t)(m0 + t) * 128 + p]; }
#pragma unroll
          for (int q = 0; q < 16; ++q) { const int t = 8 * w + (q >> 1), ii = krev + 8 * (q & 1); LAS float* hp = H2 + t * 128 + pg * 16 + ii; *hp = gelu_erf(*hp * su_[q]) * (gt_[q] * sv_[q]); } }
        LDS_WAIT(); asm volatile("" ::: "memory");
#define PX_AXPY8(R, tt_, hf_) do { const LAS f32x4* wp_ = (const LAS f32x4*)(H2 + (8 * w + (tt_)) * 128 + 8 * (hf_)) + pg4; const f32x4 w0_ = wp_[0], w1_ = wp_[1]; \
            const float wv_[8] = {w0_.x, w0_.y, w0_.z, w0_.w, w1_.x, w1_.y, w1_.z, w1_.w}; \
            _Pragma("unroll") for (int k = 0; k < 8; ++k) { const f32x2 w2v_ = {wv_[k], wv_[k]}; \
                acc_[0] += PX_CVT(R[k].x, false) * w2v_; acc_[1] += PX_CVT(R[k].x, true) * w2v_; acc_[2] += PX_CVT(R[k].y, false) * w2v_; acc_[3] += PX_CVT(R[k].y, true) * w2v_; \
                acc_[4] += PX_CVT(R[k].z, false) * w2v_; acc_[5] += PX_CVT(R[k].z, true) * w2v_; acc_[6] += PX_CVT(R[k].w, false) * w2v_; acc_[7] += PX_CVT(R[k].w, true) * w2v_; } \
            __builtin_amdgcn_sched_barrier(0); } while (0)
#define PX_TOK2(tt) do { const unsigned hb_ = *(const GAS unsigned*)((const unsigned char*)(HN + (size_t)(m0 + 8 * w + (tt)) * DM + 128 * s) + seg32 + 2u * jcol);     \
            PX_LOAD8(F.V8, RB, s, (tt), 1); __builtin_amdgcn_sched_barrier(0); \
            f32x2 acc_[8]; _Pragma("unroll") for (int k = 0; k < 8; ++k) acc_[k] = (f32x2){0.f, 0.f}; \
            PX_AXPY8(RA, (tt), 0); \
            { const int tn_ = ((tt) + 1) & 7, sn_ = s + (((tt) + 1) >> 3); if (sn_ < 16) PX_LOAD8(F.V8, RA, sn_, tn_, 0); } \
            __builtin_amdgcn_sched_barrier(0); PX_AXPY8(RB, (tt), 1); \
            const int t_ = 8 * w + (tt); \
            float v_[16], e_[8], f_[4], g_[2]; \
            _Pragma("unroll") for (int k = 0; k < 8; ++k) { v_[2 * k] = acc_[k].x; v_[2 * k + 1] = acc_[k].y; } \
            _Pragma("unroll") for (int j = 0; j < 8; ++j) { const float snd_ = pb0 ? v_[j] : v_[j + 8], kp_ = pb0 ? v_[j + 8] : v_[j]; e_[j] = kp_ + PX_DPP(snd_, 0x128); } \
            _Pragma("unroll") for (int j = 0; j < 4; ++j) { const float snd_ = pb1 ? e_[j] : e_[j + 4], kp_ = pb1 ? e_[j + 4] : e_[j]; f_[j] = kp_ + __shfl_xor(snd_, 16); } \
            _Pragma("unroll") for (int j = 0; j < 2; ++j) { const float snd_ = pb2 ? f_[j] : f_[j + 2], kp_ = pb2 ? f_[j + 2] : f_[j]; g_[j] = kp_ + __shfl_xor(snd_, 32); } \
            { unsigned char* ob_ = (unsigned char*)(F.out + (size_t)(m0 + t_) * DM + 128 * s); \
              f32x2 a_ = {bflo(hb_) + g_[0], bfhi(hb_) + g_[1]}; *(GAS f32x2*)(ob_ + seg64 + 4u * jcol) = a_; \
              SSL[t_ * 64 + lane] += a_.x * a_.x + a_.y * a_.y; } \
            __builtin_amdgcn_sched_barrier(0); } while (0)
        PX_LOAD8(F.V8, RA, 0, 0, 0);
#pragma unroll 1
        for (int s = 0; s < 16; ++s) {
#pragma unroll 1
            for (int tp = 0; tp < 8; ++tp) { PX_TOK2(tp); }
        }
#undef PX_TOK2
#undef PX_LOAD8
#undef PX_LOADX
#undef PX_AXPY8
        LDS_WAIT(); asm volatile("s_waitcnt vmcnt(0)" ::: "memory");
        { f32x4 an[8], gfv[8];
#pragma unroll
          for (int k = 0; k < 8; ++k) gfv[k] = *(const GAS f32x4*)(F.lnfg + 256 * k + 4 * lane);
#pragma unroll
          for (int k = 0; k < 8; ++k) an[k] = *((const GAS f32x4*)(F.out + (size_t)(m0 + 8 * w) * DM + 256 * k + 4 * lane));
#pragma unroll 1
          for (int tt = 0; tt < 8; ++tt) { const int t = 8 * w + tt; const float rstd = rsqrtf(wave_sum(SSL[t * 64 + lane]) * (1.f / DM) + EPS);
            float* orow = F.out + (size_t)(m0 + t) * DM; f32x4 a[8];
#pragma unroll
            for (int k = 0; k < 8; ++k) a[k] = an[k];
            if (tt + 1 < 8) {
#pragma unroll
                for (int k = 0; k < 8; ++k) an[k] = *((const GAS f32x4*)(orow + DM + 256 * k + 4 * lane)); }
#pragma unroll
            for (int k = 0; k < 8; ++k) { const f32x4 gg = gfv[k];
                a[k].x *= rstd * gg.x; a[k].y *= rstd * gg.y; a[k].z *= rstd * gg.z; a[k].w *= rstd * gg.w; *(GAS f32x4*)(orow + 256 * k + 4 * lane) = a[k]; } } }
        __syncthreads();
    }
}
}

struct Args { const float* in[15]; float* out; unsigned char* ws; int ph_lo, ph_hi; };
__global__ void __launch_bounds__(NWAVES * 64, 2) fwd(Args args) {
    extern __shared__ __attribute__((aligned(16))) unsigned char lds[];
    Frame F;
    F.lds = (LAS unsigned char*)lds;
    F.MISC = (volatile LAS unsigned*)(F.lds + MISC_OFF);
    F.tid = threadIdx.x; F.lane = F.tid & 63; F.wave = __builtin_amdgcn_readfirstlane(F.tid >> 6);
    F.G = gridDim.x; { const int bx = blockIdx.x; F.vcu = (F.G % 8 == 0) ? (bx % 8) * (F.G / 8) + bx / 8 : bx; }
    unsigned char* ws = args.ws;
    F.ctl = (gu32*)(ws + WS_CTL);
    F.x = args.in[0]; F.ln1g = args.in[1]; F.w_in = args.in[2]; F.rel_bias = args.in[3]; F.wg2 = args.in[4]; F.bgate = args.in[5]; F.gng = args.in[6]; F.w_out = args.in[7];
    F.ln2g = args.in[8]; F.w_q = args.in[9]; F.keys1 = args.in[10]; F.keys2 = args.in[11]; F.pu = args.in[12]; F.pv = args.in[13]; F.lnfg = args.in[14]; F.out = args.out;
    F.WinT = (bf16*)(ws + WS_WIN); F.WoutT = (bf16*)(ws + WS_WOUT); F.WqT = (bf16*)(ws + WS_WQ); F.XN = (bf16*)(ws + WS_XN); F.MIX = (bf16*)(ws + WS_MIX); F.HN = (bf16*)(ws + WS_HN); F.PROJ = (bf16*)(ws + WS_PROJ); F.PQ = (bf16*)(ws + WS_PROJ);
    F.U8 = ws + WS_U; F.V8 = ws + WS_V; F.SC = (float*)(ws + WS_SC); F.GA = (float*)(ws + WS_GA); F.IDX = (int*)(ws + WS_IDX); F.GATE = (float*)(ws + WS_GATE); F.LB = (float*)(ws + WS_LB); F.SSQ = (float*)(ws + WS_SSQ); F.RSTD = (float*)(ws + WS_RSTD); F.RMS1 = (float*)(ws + WS_RMS1); F.XQ8 = ws + WS_XQ8; F.XN8 = ws + WS_XN8; F.WIN8 = ws + WS_WIN8; F.MIX8 = ws + WS_MIX8; F.WOUT8 = ws + WS_WOUT8; F.WQ8 = ws + WS_WQ8; F.H18 = ws + WS_H18;
    for (int u = F.tid; u < (LDS_BYTES - LDSCTL_OFF) / 4; u += NWAVES * 64) ((LAS unsigned*)(F.lds + LDSCTL_OFF))[u] = 0u;
    __syncthreads();
    XcdBarrier bar; bar.bar = (unsigned*)(F.ctl + CW_BAR); bar.x = 0; bar.st = nullptr;
    if (N_LAUNCHES != PER_PHASE) bar = xcd_barrier_post((unsigned*)(F.ctl + CW_BAR), F.MISC + 8);
#define GRID_BAR(seam) do { if (N_LAUNCHES == PER_PHASE) { if (F.tid == 0) __hip_atomic_store(F.ctl + CW_TMO, 0xBADBA0u | (unsigned)(seam), RLX_AGENT); } else { xcd_barrier(bar); } } while (0)
    const int lo = args.ph_lo, hi = args.ph_hi;
#define IN(k) (lo <= (k) && (k) < hi)
#define BOTH(k) (IN(k) && IN((k) + 1))

    if (IN(0)) { p0_prologue(F); if (BOTH(0)) GRID_BAR(0); }

    if (IN(1)) {
        ga_mfma(F);
        __syncthreads();
        { pg8::Gemm g{(const pg8::bf16_t*)F.XN8, (const pg8::bf16_t*)F.WIN8, T, F8_A1 - F8_A0, DM / 2}; pg8::StaticOrder S; S.init(T, F8_A1 - F8_A0, F.G, (int)blockIdx.x);
          pg8::EpiProj E{F.PROJ, NPROJ, 1.f / WIN8_SCALE, F8_A0 / 256};
          pg8::gemm_phase<pg8::EpiProj, pg8::StaticOrder, true, true, true>(F.lds + RING_OFF, g, S, E); }
        __syncthreads();
        { pg8::Gemm g{F.XN, F.WinT + (size_t)F8_A1 * DM, T, F8_B0 - F8_A1, DM}; pg8::StaticOrder S; S.init(T, F8_B0 - F8_A1, F.G, (int)blockIdx.x);
          pg8::EpiProj E{F.PROJ, NPROJ, 1.f, F8_A1 / 256};
          pg8::gemm_phase<pg8::EpiProj, pg8::StaticOrder, true, true, false>(F.lds + RING_OFF, g, S, E); }
        __syncthreads();
        { pg8::Gemm g{(const pg8::bf16_t*)F.XN8, (const pg8::bf16_t*)(F.WIN8 + (size_t)F8_B0 * DM), T, F8_B1 - F8_B0, DM / 2}; pg8::StaticOrder S; S.init(T, F8_B1 - F8_B0, F.G, (int)blockIdx.x);
          pg8::EpiProj E{F.PROJ, NPROJ, 1.f / WIN8_SCALE, F8_B0 / 256};
          pg8::gemm_phase<pg8::EpiProj, pg8::StaticOrder, true, true, true>(F.lds + RING_OFF, g, S, E); }
        if (BOTH(1)) GRID_BAR(1);
    }

    if (IN(2)) {
        for (int it = F.vcu; it < gla::NITEM; it += F.G) gla::gla_pre_item(F, it >> 7, (it >> 5) & 3, it & 31, it);
        GRID_BAR(8);
        gla::gla_scan(F);
        GRID_BAR(9);
        att::attn_phase(F, F.ctl + CW_ATTQ, gla::NITEM, [&](int it) { gla::gla_post_item(F, it >> 7, (it >> 5) & 3, it & 31, it); });
        if (BOTH(2)) GRID_BAR(2);
    }

    if (IN(3)) {
        pg8::Gemm g{(const pg8::bf16_t*)F.MIX8, (const pg8::bf16_t*)F.WOUT8, T, DM, DM / 2}; pg8::StaticOrder S; S.init(T, DM, F.G, (int)blockIdx.x);
        pg8::EpiRes2 E{(const pg8::bf16_t*)F.XN, F.RMS1, F.ln1g, (pg8::bf16_t*)F.HN, F.SSQ, DM, T};
        pg8::gemm_phase<pg8::EpiRes2, pg8::StaticOrder, true, true, true>(F.lds + RING_OFF, g, S, E);
        if (IN(5)) GRID_BAR(3);
    }


    if (IN(5)) {
        pg8::Gemm g{(const pg8::bf16_t*)F.H18, (const pg8::bf16_t*)F.WQ8, T, DM, DM / 2}; pg8::StaticOrder S; S.init(T, DM, F.G, (int)blockIdx.x);
        pg8::EpiBf16<0> E{F.PQ, DM, nullptr, DM, 0, 1.f / (WIN8_SCALE * H18_SCALE)};
        pg8::gemm_phase<pg8::EpiBf16<0>, pg8::StaticOrder, true, true, true>(F.lds + RING_OFF, g, S, E);
        if (BOTH(5)) GRID_BAR(5);
    }

    if (IN(6)) { pks::peer_score(F); if (BOTH(6)) { asm volatile("s_waitcnt vmcnt(0)" ::: "memory"); __syncthreads(); } }

    if (IN(7)) { pex::peer_experts(F); }
#undef IN
#undef BOTH
}

extern "C" void kernel_launch(void* const* d_in, const int* in_sizes, int n_in, void* d_out, int out_size, void* d_ws, size_t ws_size, hipStream_t stream) {
    static int grid = 0;
    if (grid == 0) {
        if (n_in != 15 || in_sizes[0] != T * DM || out_size != T * DM || ws_size < WS_END) { fprintf(stderr, "kernel_launch: unexpected shapes (n_in %d in0 %d out %d ws %zu)\n", n_in, n_in > 0 ? in_sizes[0] : -1, out_size, ws_size); grid = -1; return; }
        int dev = 0, cus = 0, per_cu = 0;
        if (hipGetDevice(&dev) != hipSuccess || hipDeviceGetAttribute(&cus, hipDeviceAttributeMultiprocessorCount, dev) != hipSuccess) { grid = -1; return; }
        if (hipFuncSetAttribute((const void*)fwd, hipFuncAttributeMaxDynamicSharedMemorySize, LDS_BYTES) != hipSuccess) { fprintf(stderr, "kernel_launch: hipFuncSetAttribute failed\n"); grid = -1; return; }
        if (hipOccupancyMaxActiveBlocksPerMultiprocessor(&per_cu, (const void*)fwd, NWAVES * 64, LDS_BYTES) != hipSuccess || per_cu < 1) fprintf(stderr, "kernel_launch: occupancy query reports %d\n", per_cu);
        (void)hipGetLastError();
        grid = cus;
    }
    if (grid < 0) return;
    if (hipMemsetAsync((char*)d_ws + WS_CTL, 0, CTL_ZERO_BYTES, stream) != hipSuccess) return;
    Args a{};
    for (int i = 0; i < 15; ++i) a.in[i] = (const float*)d_in[i];
    a.out = (float*)d_out; a.ws = (unsigned char*)d_ws;
    for (int li = 0; li < N_LAUNCHES; ++li) {
        a.ph_lo = (N_LAUNCHES == PER_PHASE) ? li : 0; a.ph_hi = (N_LAUNCHES == PER_PHASE) ? li + 1 : PER_PHASE;
        hipLaunchKernelGGL(fwd, dim3(grid), dim3(NWAVES * 64), LDS_BYTES, stream, a);
        const hipError_t le = hipPeekAtLastError();
        if (le != hipSuccess) { fprintf(stderr, "kernel_launch: launch %d failed: %s\n", li, hipGetErrorName(le)); break; }
    }
}
```
